# Optimizing an MI355X kernel written in HIP

```python
import math
import jax, jax.numpy as jnp
from jax import lax
import numpy as np

D_MODEL = 1024
BATCH = 8
SEQ = 4096
DEPTH = 2
DEC_BATCH = 16
DEC_SEQ = 2048
PAST_LEN = 128

N_MEM = 256
EPS = 1e-6
NEG_INF = -1e30
DIL_GROUPS = ((128, 1), (512, 4), (2048, 16))
N_DIL = 3
DIL_HEADS = 4
DIL_HEAD_DIM = 128
DIL_WIDTH = N_DIL * DIL_HEADS * DIL_HEAD_DIM
DIL_OUT = DIL_HEADS * DIL_HEAD_DIM
MLA_HEADS = 8
MLA_Q_LORA = 384
MLA_KV_LORA = 256
MLA_NOPE = 64
MLA_ROPE = 32
MLA_QK = MLA_NOPE + MLA_ROPE
MLA_V = 64
MLA_OUT = MLA_HEADS * MLA_V
ROPE_THETA = 10000.0
Q_BLOCK = 128
MEM_HEADS = 4
MEM_HEAD_DIM = 128
MEM_WIDTH = MEM_HEADS * MEM_HEAD_DIM
N_BRANCH = 3
BRANCH_WIDTH = 512
D_FF = 4 * D_MODEL
IN_SPLITS = (DIL_WIDTH, DIL_WIDTH, DIL_WIDTH, MLA_Q_LORA, MLA_KV_LORA, MLA_ROPE, MEM_WIDTH, N_BRANCH * D_MODEL)
D_IN = 3 * DIL_WIDTH + MLA_Q_LORA + MLA_KV_LORA + MLA_ROPE + MEM_WIDTH + N_BRANCH * D_MODEL

kernel_name = "hybrid_dilated_mla_memory_encoder"


def rmsnorm(x, g):
    xf = x.astype(jnp.float32)
    r = lax.rsqrt(jnp.mean(xf * xf, axis=-1, keepdims=True) + EPS)
    return (xf * r).astype(x.dtype) * g


def alibi_slopes():
    n = N_DIL * DIL_HEADS
    s = np.array([2.0 ** (-8.0 * (k + 1) / n) for k in range(n)], dtype=np.float32)
    return jnp.asarray(s.reshape(N_DIL, DIL_HEADS))


def split_cols(z):
    outs, off = [], 0
    for w in IN_SPLITS:
        outs.append(z[..., off:off + w])
        off += w
    return outs


def rope(x, S):
    half = MLA_ROPE // 2
    inv = ROPE_THETA ** (-jnp.arange(half, dtype=jnp.float32) * 2.0 / MLA_ROPE)
    ang = jnp.arange(S, dtype=jnp.float32)[:, None] * inv[None, :]
    c = jnp.cos(ang)[None, :, None, :].astype(x.dtype)
    s = jnp.sin(ang)[None, :, None, :].astype(x.dtype)
    x1, x2 = x[..., :half], x[..., half:]
    return jnp.concatenate([x1 * c - x2 * s, x1 * s + x2 * c], axis=-1)


def dilated_group(q, k, v, slopes, window, dilation):
    B, S, H, Dh = q.shape
    R = window // (2 * dilation)
    L = S // dilation
    nb = -(-L // R)
    Lp = nb * R

    def by_residue(t):
        t = t.reshape(B, L, dilation, H, Dh).transpose(0, 2, 1, 3, 4)
        return jnp.pad(t, ((0, 0), (0, 0), (0, Lp - L), (0, 0), (0, 0)))

    def windows(t):
        t = jnp.pad(by_residue(t), ((0, 0), (0, 0), (R, R), (0, 0), (0, 0)))
        t = t.reshape(B, dilation, nb + 2, R, H, Dh)
        return jnp.concatenate([t[:, :, :-2], t[:, :, 1:-1], t[:, :, 2:]], axis=3)

    qs = by_residue(q).reshape(B, dilation, nb, R, H, Dh)
    ks = windows(k)
    vs = windows(v)
    s = jnp.einsum('bgnqhd,bgnkhd->bghnqk', qs, ks).astype(jnp.float32) / math.sqrt(Dh)
    a = jnp.arange(R)[:, None]
    c = jnp.arange(3 * R)[None, :]
    rel = c - R - a
    ku = jnp.arange(nb)[:, None, None] * R - R + c[None]
    mask = (jnp.abs(rel)[None] <= R) & (ku >= 0) & (ku < L)
    dist = (jnp.abs(rel) * dilation).astype(jnp.float32)
    bias = -slopes.astype(jnp.float32)[:, None, None, None] * dist[None, None]
    s = jnp.where(mask, s + bias, NEG_INF)
    m = jnp.max(s, axis=-1, keepdims=True)
    p = jnp.exp(s - m)
    den = jnp.sum(p, axis=-1, keepdims=True)
    o = jnp.einsum('bghnqk,bgnkhd->bgnqhd', p.astype(v.dtype), vs).astype(jnp.float32)
    o = o / den[..., 0].transpose(0, 1, 3, 4, 2)[..., None]
    lse = (m + jnp.log(den))[..., 0].transpose(0, 1, 3, 4, 2)
    o = o.reshape(B, dilation, Lp, H, Dh)[:, :, :L].transpose(0, 2, 1, 3, 4).reshape(B, S, H, Dh)
    lse = lse.reshape(B, dilation, Lp, H)[:, :, :L].transpose(0, 2, 1, 3).reshape(B, S, H)
    return o, lse


def dilated_attention(q, k, v, q_g, k_g):
    B, S, _ = q.shape
    shp = (B, S, N_DIL, DIL_HEADS, DIL_HEAD_DIM)
    q = rmsnorm(q.reshape(shp), q_g)
    k = rmsnorm(k.reshape(shp), k_g)
    v = v.reshape(shp)
    slopes = alibi_slopes()
    outs, lses = [], []
    for g, (win, dil) in enumerate(DIL_GROUPS):
        o, l = dilated_group(q[:, :, g], k[:, :, g], v[:, :, g], slopes[g], win, dil)
        outs.append(o)
        lses.append(l)
    w = jax.nn.softmax(jnp.stack(lses, 0), axis=0)
    o = jnp.sum(w[..., None] * jnp.stack(outs, 0), axis=0)
    return o.reshape(B, S, DIL_OUT).astype(q.dtype)


def mla_attention(c_q, c_kv, k_rope, q_a_g, kv_a_g, w_q_b, w_kv_b, q_g, k_g):
    B, S, _ = c_q.shape
    q = (rmsnorm(c_q, q_a_g) @ w_q_b).reshape(B, S, MLA_HEADS, MLA_QK)
    kv = (rmsnorm(c_kv, kv_a_g) @ w_kv_b).reshape(B, S, MLA_HEADS, MLA_NOPE + MLA_V)
    k_nope, v = kv[..., :MLA_NOPE], kv[..., MLA_NOPE:]
    k = jnp.concatenate([k_nope, jnp.broadcast_to(k_rope[:, :, None, :], (B, S, MLA_HEADS, MLA_ROPE))], -1)
    q = rmsnorm(q, q_g)
    k = rmsnorm(k, k_g)
    q = jnp.concatenate([q[..., :MLA_NOPE], rope(q[..., MLA_NOPE:], S)], -1)
    k = jnp.concatenate([k[..., :MLA_NOPE], rope(k[..., MLA_NOPE:], S)], -1)
    scale = 1.0 / math.sqrt(MLA_QK)
    nq = S // Q_BLOCK
    qb = q.reshape(B, nq, Q_BLOCK, MLA_HEADS, MLA_QK).transpose(1, 0, 2, 3, 4)

    def block(qi):
        s = jnp.einsum('bqhd,bkhd->bhqk', qi, k).astype(jnp.float32) * scale
        p = jax.nn.softmax(s, axis=-1).astype(v.dtype)
        return jnp.einsum('bhqk,bkhd->bqhd', p, v)

    o = lax.map(block, qb)
    return o.transpose(1, 0, 2, 3, 4).reshape(B, S, MLA_OUT)


def memory_attention(q, mem, mem_g, w_mem_kv, q_g, k_g):
    B, S, _ = q.shape
    M = mem.shape[1]
    kv = rmsnorm(mem, mem_g) @ w_mem_kv
    k = rmsnorm(kv[..., :MEM_WIDTH].reshape(B, M, MEM_HEADS, MEM_HEAD_DIM), k_g)
    v = kv[..., MEM_WIDTH:].reshape(B, M, MEM_HEADS, MEM_HEAD_DIM)
    q = rmsnorm(q.reshape(B, S, MEM_HEADS, MEM_HEAD_DIM), q_g)
    s = jnp.einsum('bshd,bmhd->bhsm', q, k).astype(jnp.float32) / math.sqrt(MEM_HEAD_DIM)
    p = jax.nn.softmax(s, axis=-1).astype(v.dtype)
    return jnp.einsum('bhsm,bmhd->bshd', p, v).reshape(B, S, MEM_WIDTH)


def encoder_layer(x, mem, l, mix_norm, w_in, dil_q_norm, dil_k_norm, mla_q_a_norm, mla_kv_a_norm,
                  w_mla_q_b, w_mla_kv_b, mla_q_norm, mla_k_norm, mem_norm, w_mem_kv, mem_q_norm,
                  mem_k_norm, w_branch, w_out, ffn_norm, w_ff1, w_ff2):
    B, S, _ = x.shape
    h = rmsnorm(x, mix_norm[l])
    z = h @ w_in[l]
    dq, dk, dv, c_q, c_kv, k_rope, mq, gl = split_cols(z)
    a = dilated_attention(dq, dk, dv, dil_q_norm[l], dil_k_norm[l])
    b = mla_attention(c_q, c_kv, k_rope, mla_q_a_norm[l], mla_kv_a_norm[l], w_mla_q_b[l], w_mla_kv_b[l],
                      mla_q_norm[l], mla_k_norm[l])
    m = memory_attention(mq, mem, mem_norm[l], w_mem_kv[l], mem_q_norm[l], mem_k_norm[l])
    br = jnp.stack([a, b, m], axis=2)
    proj = jnp.einsum('bsnc,ncd->bsnd', br, w_branch[l])
    gates = jax.nn.sigmoid(gl.reshape(B, S, N_BRANCH, D_MODEL))
    x = x + jnp.sum(gates * proj, axis=2) @ w_out[l]
    h2 = rmsnorm(x, ffn_norm[l])
    x = x + jnp.square(jax.nn.relu(h2 @ w_ff1[l])) @ w_ff2[l]
    return x


def setup_inputs(seed: int = 0) -> dict:
    key = jax.random.key(seed)
    ks = jax.random.split(key, 24)
    f32 = jnp.float32

    def w(k, shape, fan_in):
        return jax.random.normal(k, shape, f32) * (fan_in ** -0.5)

    def gain(k, shape):
        return 1.0 + 0.02 * jax.random.normal(k, shape, f32)

    return {
        "x_prompt": jax.random.normal(ks[0], (BATCH, SEQ, D_MODEL), f32),
        "x_sample": jax.random.normal(ks[1], (DEC_BATCH, DEC_SEQ, D_MODEL), f32),
        "mem_prompt": jax.random.normal(ks[2], (BATCH, N_MEM, D_MODEL), f32),
        "mem_sample": jax.random.normal(ks[3], (DEC_BATCH, N_MEM, D_MODEL), f32),
        "mix_norm": gain(ks[4], (DEPTH, D_MODEL)),
        "w_in": w(ks[5], (DEPTH, D_MODEL, D_IN), D_MODEL),
        "dil_q_norm": gain(ks[6], (DEPTH, N_DIL, DIL_HEADS, DIL_HEAD_DIM)),
        "dil_k_norm": gain(ks[7], (DEPTH, N_DIL, DIL_HEADS, DIL_HEAD_DIM)),
        "mla_q_a_norm": gain(ks[8], (DEPTH, MLA_Q_LORA)),
        "mla_kv_a_norm": gain(ks[9], (DEPTH, MLA_KV_LORA)),
        "w_mla_q_b": w(ks[10], (DEPTH, MLA_Q_LORA, MLA_HEADS * MLA_QK), MLA_Q_LORA),
        "w_mla_kv_b": w(ks[11], (DEPTH, MLA_KV_LORA, MLA_HEADS * (MLA_NOPE + MLA_V)), MLA_KV_LORA),
        "mla_q_norm": gain(ks[12], (DEPTH, MLA_QK)),
        "mla_k_norm": gain(ks[13], (DEPTH, MLA_QK)),
        "mem_norm": gain(ks[14], (DEPTH, D_MODEL)),
        "w_mem_kv": w(ks[15], (DEPTH, D_MODEL, 2 * MEM_WIDTH), D_MODEL),
        "mem_q_norm": gain(ks[16], (DEPTH, MEM_HEAD_DIM)),
        "mem_k_norm": gain(ks[17], (DEPTH, MEM_HEAD_DIM)),
        "w_branch": w(ks[18], (DEPTH, N_BRANCH, BRANCH_WIDTH, D_MODEL), BRANCH_WIDTH),
        "w_out": w(ks[19], (DEPTH, D_MODEL, D_MODEL), D_MODEL),
        "ffn_norm": gain(ks[20], (DEPTH, D_MODEL)),
        "w_ff1": w(ks[21], (DEPTH, D_MODEL, D_FF), D_MODEL),
        "w_ff2": w(ks[22], (DEPTH, D_FF, D_MODEL), D_FF),
    }


def reference(x_prompt, x_sample, mem_prompt, mem_sample, mix_norm, w_in, dil_q_norm, dil_k_norm,
              mla_q_a_norm, mla_kv_a_norm, w_mla_q_b, w_mla_kv_b, mla_q_norm, mla_k_norm, mem_norm,
              w_mem_kv, mem_q_norm, mem_k_norm, w_branch, w_out, ffn_norm, w_ff1, w_ff2):
    yp = x_prompt
    ys = x_sample
    for l in range(DEPTH):
        yp = encoder_layer(yp, mem_prompt, l, mix_norm, w_in, dil_q_norm, dil_k_norm, mla_q_a_norm,
                           mla_kv_a_norm, w_mla_q_b, w_mla_kv_b, mla_q_norm, mla_k_norm, mem_norm,
                           w_mem_kv, mem_q_norm, mem_k_norm, w_branch, w_out, ffn_norm, w_ff1, w_ff2)
        ys = encoder_layer(ys, mem_sample, l, mix_norm, w_in, dil_q_norm, dil_k_norm, mla_q_a_norm,
                           mla_kv_a_norm, w_mla_q_b, w_mla_kv_b, mla_q_norm, mla_k_norm, mem_norm,
                           w_mem_kv, mem_q_norm, mem_k_norm, w_branch, w_out, ffn_norm, w_ff1, w_ff2)
    return (yp, ys)
```

```cpp
#include <hip/hip_runtime.h>
#include <hip/hip_cooperative_groups.h>
#include <cstdio>
#include <cstdint>
namespace cg = cooperative_groups;

#ifndef MULTI_LAUNCH
#define MULTI_LAUNCH 0
#endif

typedef unsigned short u16;
using bf16x8 = __attribute__((ext_vector_type(8))) short;
using f32x16 = __attribute__((ext_vector_type(16))) float;
using f32x4  = __attribute__((ext_vector_type(4))) float;
using u32x4  = __attribute__((ext_vector_type(4))) unsigned;
using u32x2  = __attribute__((ext_vector_type(2))) unsigned;
typedef __bf16 bf2_t __attribute__((ext_vector_type(2)));
typedef float f2_t __attribute__((ext_vector_type(2)));
#define DI __device__ __forceinline__
#define GAS __attribute__((address_space(1)))
#define MFMA(a, b, c) __builtin_amdgcn_mfma_f32_32x32x16_bf16((a), (b), (c), 0, 0, 0)

constexpr int DM = 1024, DIN = 8864, DINP = 8960, DFF = 4096;
constexpr int CT = 16384;
constexpr int NCHUNK = 4;
constexpr int MTS = 7, MTN = 128;
constexpr float EPS = 1e-6f;
constexpr float LOG2E = 1.4426950408889634f, LN2 = 0.6931471805599453f;
constexpr float QS128 = LOG2E * 0.08838834764831845f;
constexpr float QS96  = LOG2E * 0.10206207261596575f;

constexpr size_t SZ_WIN = (size_t)DINP * 1024 * 2, SZ_WQB = 1024ull * 384 * 2, SZ_WKVB = 1024ull * 256 * 2, SZ_WMEM = 1024ull * 1024 * 2;
constexpr size_t SZ_WBR = 1024ull * 512 * 2, SZ_WOUT = 1024ull * 1024 * 2, SZ_WFF1 = 4096ull * 1024 * 2, SZ_WFF2 = 1024ull * 4096 * 2;
constexpr size_t SZ_KMEM = 6144ull * 512 * 2;
constexpr size_t OFF_WIN = 0;
constexpr size_t OFF_WQB = OFF_WIN + 2 * SZ_WIN;
constexpr size_t OFF_WKVB = OFF_WQB + 2 * SZ_WQB;
constexpr size_t OFF_WMEM = OFF_WKVB + 2 * SZ_WKVB;
constexpr size_t OFF_WBR = OFF_WMEM + 2 * SZ_WMEM;
constexpr size_t OFF_WOUT = OFF_WBR + 6 * SZ_WBR;
constexpr size_t OFF_WFF1 = OFF_WOUT + 2 * SZ_WOUT;
constexpr size_t OFF_WFF2 = OFF_WFF1 + 2 * SZ_WFF1;
constexpr size_t OFF_KMEM = OFF_WFF2 + 2 * SZ_WFF2;
constexpr size_t OFF_VMEMT = OFF_KMEM + 2 * SZ_KMEM;
constexpr size_t OFF_QD = OFF_VMEMT + 2 * SZ_KMEM;
constexpr size_t SZ_D3 = 3ull * CT * 512 * 2;
constexpr size_t OFF_KD = OFF_QD + SZ_D3;
constexpr size_t OFF_VDT = OFF_KD + SZ_D3;
constexpr size_t OFF_CQ = OFF_VDT + SZ_D3;
constexpr size_t OFF_CKV = OFF_CQ + (size_t)CT * 384 * 2;
constexpr size_t OFF_KR = OFF_CKV + (size_t)CT * 256 * 2;
constexpr size_t OFF_MQ = OFF_KR + (size_t)CT * 32 * 2;
constexpr size_t OFF_QM = OFF_MQ + (size_t)CT * 512 * 2;
constexpr size_t OFF_KM = OFF_QM + (size_t)CT * 768 * 2;
constexpr size_t OFF_VMT = OFF_KM + (size_t)CT * 768 * 2;
constexpr size_t OFF_AO = OFF_VMT + (size_t)CT * 512 * 2;
constexpr size_t OFF_LSE = OFF_AO + SZ_D3;
constexpr size_t OFF_BR = OFF_LSE + 3ull * CT * 4 * 4;
constexpr size_t OFF_U = OFF_QM;
constexpr size_t OFF_H = OFF_QD;
static_assert((size_t)CT * 1024 * 2 <= 2 * (size_t)CT * 768 * 2 && (size_t)CT * 4096 * 2 <= 3 * SZ_D3, "overlay sizes");
constexpr size_t OFF_BAR = OFF_BR + 3ull * CT * 512 * 2;
constexpr size_t OFF_GAINS = OFF_BAR + 16384;
constexpr int GN_DQ = 0, GN_DK = 3072, GN_MQ = 6144, GN_MK = 6336, GN_MEMQ = 6528, GN_MEMK = 6784, GN_TOTAL = 7040;
constexpr size_t OFF_XB = OFF_GAINS + 32768;
constexpr size_t OFF_PSIN = OFF_XB + (size_t)CT * 1024 * 2;
constexpr size_t OFF_PSMID = OFF_PSIN + (size_t)CT * 16 * 4;
constexpr size_t WS_END = OFF_PSMID + (size_t)CT * 16 * 4;

struct Params {
  const float* x_prompt; const float* x_sample; const float* mem_prompt; const float* mem_sample;
  const float* mix_norm; const float* w_in; const float* dil_q_norm; const float* dil_k_norm;
  const float* mla_q_a_norm; const float* mla_kv_a_norm; const float* w_mla_q_b; const float* w_mla_kv_b;
  const float* mla_q_norm; const float* mla_k_norm; const float* mem_norm; const float* w_mem_kv;
  const float* mem_q_norm; const float* mem_k_norm; const float* w_branch; const float* w_out;
  const float* ffn_norm; const float* w_ff1; const float* w_ff2;
  float* out; char* ws;
};

struct Chunk { int S; int sshift; int nb; int tok0; int mb0; };
DI Chunk make_chunk(int c) {
  Chunk k;
  if (c < 2) { k.S = 4096; k.sshift = 12; k.nb = 4; k.tok0 = c * CT; k.mb0 = c * 4; }
  else { k.S = 2048; k.sshift = 11; k.nb = 8; k.tok0 = 32768 + (c - 2) * CT; k.mb0 = 8 + (c - 2) * 8; }
  return k;
}

DI const float* chunk_xsrc(const Params& p, int l, const Chunk& ck) {
  GAS const float* x0 = (GAS const float*)((ck.tok0 < 32768) ? p.x_prompt + (size_t)ck.tok0 * 1024 : p.x_sample + (size_t)(ck.tok0 - 32768) * 1024);
  asm volatile("" : "+v"(x0));
  const float* x1 = p.out + (size_t)ck.tok0 * 1024;
  return (l == 0) ? (const float*)x0 : x1;
}

DI int TID() { int t = (int)__builtin_amdgcn_workitem_id_x(); asm volatile("" : "+v"(t)); return t; }
DI int BID() { int b = (int)__builtin_amdgcn_workgroup_id_x(); asm volatile("" : "+s"(b)); return b; }
DI unsigned pk2(float a, float b) { f2_t v = {a, b}; bf2_t r = __builtin_convertvector(v, bf2_t); return __builtin_bit_cast(unsigned, r); }
DI u32x4 pack8(const float (&v)[8]) { u32x4 r = {pk2(v[0], v[1]), pk2(v[2], v[3]), pk2(v[4], v[5]), pk2(v[6], v[7])}; return r; }
DI void unpack8(u32x4 u, float (&f)[8]) {
#pragma unroll
  for (int i = 0; i < 4; ++i) { f[2 * i] = __uint_as_float(u[i] << 16); f[2 * i + 1] = __uint_as_float(u[i] & 0xffff0000u); }
}
DI int crow(int r, int hi) { return (r & 3) + 8 * (r >> 2) + 4 * hi; }
DI float bf2f(u16 v) { return __uint_as_float(((unsigned)v) << 16); }

constexpr int LDT = 72;
constexpr int CSL = 132;
constexpr int GBUF = 2 * 128 * LDT;
constexpr int SMEM_CS = 2 * GBUF * 2;
constexpr int SMEM_BYTES = SMEM_CS + 512;

DI void cs_ld8(const float* Cs, int row, int col, float (&v)[8]) {
  const f32x4 a = *(const f32x4*)&Cs[row * CSL + col]; const f32x4 b = *(const f32x4*)&Cs[row * CSL + col + 4];
  v[0] = a[0]; v[1] = a[1]; v[2] = a[2]; v[3] = a[3]; v[4] = b[0]; v[5] = b[1]; v[6] = b[2]; v[7] = b[3];
}
DI void st8(u16* dst, const float (&v)[8]) { *(u32x4*)dst = pack8(v); }

template <bool AF32, bool ROWNORM, int KSU = 4>
DI void gemm_main(const void* __restrict__ Ap, int lda, const u16* __restrict__ Wt, int K, f32x16 (&acc)[2][2], char* smem, float* rinv_s) {
  const int tid = TID(), lane = tid & 63, w = tid >> 6, wm = w >> 1, wn = w & 1, r32 = lane & 31, hi = lane >> 5;
  u16* As = (u16*)smem; u16* Bs = As + 128 * LDT;
  const int srow = tid >> 3, sc8 = (tid & 7) * 8;
  float ss[4] = {0.f, 0.f, 0.f, 0.f};
  f32x4 af[8]; u32x4 ab[4]; u32x4 bb[4];
  const int nk = K >> 6;
#define GLOAD(kt) do { _Pragma("unroll") for (int i = 0; i < 4; ++i) { \
    if constexpr (AF32) { const float* a_ = (const float*)Ap + (size_t)(srow + 32 * i) * lda + (kt) * 64 + sc8; af[2 * i] = *(const f32x4*)a_; af[2 * i + 1] = *(const f32x4*)(a_ + 4); } \
    else { const u16* a_ = (const u16*)Ap + (size_t)(srow + 32 * i) * lda + (kt) * 64 + sc8; ab[i] = *(const u32x4*)a_; } \
    bb[i] = *(const u32x4*)(Wt + (size_t)(srow + 32 * i) * K + (kt) * 64 + sc8); } } while (0)
#define GSTORE(buf) do { _Pragma("unroll") for (int i = 0; i < 4; ++i) { \
    u32x4 av; \
    if constexpr (AF32) { const f32x4 lo = af[2 * i], h4 = af[2 * i + 1]; \
      av = u32x4{pk2(lo[0], lo[1]), pk2(lo[2], lo[3]), pk2(h4[0], h4[1]), pk2(h4[2], h4[3])}; \
      if constexpr (ROWNORM) ss[i] += lo[0] * lo[0] + lo[1] * lo[1] + lo[2] * lo[2] + lo[3] * lo[3] + h4[0] * h4[0] + h4[1] * h4[1] + h4[2] * h4[2] + h4[3] * h4[3]; \
    } else { av = ab[i]; \
      if constexpr (ROWNORM) { float f[8]; unpack8(av, f); _Pragma("unroll") for (int j = 0; j < 8; ++j) ss[i] += f[j] * f[j]; } } \
    *(u32x4*)&As[(buf) * GBUF + (srow + 32 * i) * LDT + sc8] = av; \
    *(u32x4*)&Bs[(buf) * GBUF + (srow + 32 * i) * LDT + sc8] = bb[i]; } } while (0)
  GLOAD(0);
  __syncthreads();
  GSTORE(0);
  __syncthreads();
  for (int kt = 0; kt < nk; ++kt) {
    const int cur = (kt & 1) * GBUF;
    if (kt + 1 < nk) GLOAD(kt + 1);
#pragma unroll KSU
    for (int ks = 0; ks < 4; ++ks) {
      const bf16x8 a0 = *(const bf16x8*)&As[cur + (wm * 64 + r32) * LDT + ks * 16 + hi * 8];
      const bf16x8 a1 = *(const bf16x8*)&As[cur + (wm * 64 + 32 + r32) * LDT + ks * 16 + hi * 8];
      const bf16x8 b0 = *(const bf16x8*)&Bs[cur + (wn * 64 + r32) * LDT + ks * 16 + hi * 8];
      const bf16x8 b1 = *(const bf16x8*)&Bs[cur + (wn * 64 + 32 + r32) * LDT + ks * 16 + hi * 8];
      acc[0][0] = MFMA(a0, b0, acc[0][0]); acc[0][1] = MFMA(a0, b1, acc[0][1]);
      acc[1][0] = MFMA(a1, b0, acc[1][0]); acc[1][1] = MFMA(a1, b1, acc[1][1]);
    }
    if (kt + 1 < nk) { const int nb_ = ((kt + 1) & 1); GSTORE(nb_); }
    __syncthreads();
  }
#undef GSTORE
#undef GLOAD
  if constexpr (ROWNORM) {
#pragma unroll
    for (int i = 0; i < 4; ++i) {
      float s = ss[i]; s += __shfl_xor(s, 1); s += __shfl_xor(s, 2); s += __shfl_xor(s, 4);
      if ((tid & 7) == 0) rinv_s[srow + 32 * i] = rsqrtf(s / (float)K + EPS);
    }
  }
}

template <bool ROWNORM, int NK>
DI void gemm_main_bf(const u16* __restrict__ Ap, int lda, const u16* __restrict__ Wt, f32x16 (&acc)[2][2], char* smem, float* rinv_s) {
  constexpr int K = NK * 64;
  const int tid = TID(), lane = tid & 63, w = tid >> 6, wm = w >> 1, wn = w & 1, r32 = lane & 31, hi = lane >> 5;
  u16* As = (u16*)smem; u16* Bs = As + 128 * LDT;
  const int srow = tid >> 3, sc8 = (tid & 7) * 8;
  float ss[4] = {0.f, 0.f, 0.f, 0.f};
  u32x4 a0[4], b0[4], a1[4], b1[4];
  constexpr int nk = NK;
  const unsigned aoff = (unsigned)(srow * lda + sc8) * 2u, woff = (unsigned)(srow * K + sc8) * 2u;
#define BLOAD(A_, B_, kt) do { _Pragma("unroll") for (int i = 0; i < 4; ++i) { \
    A_[i] = *(const u32x4*)((const char*)Ap + (aoff + (unsigned)(32 * i * lda + (kt) * 64) * 2u)); B_[i] = *(const u32x4*)((const char*)Wt + (woff + (unsigned)(32 * i * K + (kt) * 64) * 2u)); } } while (0)
#define BSTORE(A_, B_, buf) do { _Pragma("unroll") for (int i = 0; i < 4; ++i) { \
    if constexpr (ROWNORM) { float f[8]; unpack8(A_[i], f); _Pragma("unroll") for (int j = 0; j < 8; ++j) ss[i] += f[j] * f[j]; asm volatile("" : "+v"(ss[i])); } \
    *(u32x4*)&As[(buf) * GBUF + (srow + 32 * i) * LDT + sc8] = A_[i]; \
    *(u32x4*)&Bs[(buf) * GBUF + (srow + 32 * i) * LDT + sc8] = B_[i]; } } while (0)
#define BCOMP(buf) do { __builtin_amdgcn_s_setprio(1); _Pragma("unroll") for (int ks = 0; ks < 4; ++ks) { \
      const bf16x8 fa0 = *(const bf16x8*)&As[(buf) * GBUF + (wm * 64 + r32) * LDT + ks * 16 + hi * 8]; \
      const bf16x8 fa1 = *(const bf16x8*)&As[(buf) * GBUF + (wm * 64 + 32 + r32) * LDT + ks * 16 + hi * 8]; \
      const bf16x8 fb0 = *(const bf16x8*)&Bs[(buf) * GBUF + (wn * 64 + r32) * LDT + ks * 16 + hi * 8]; \
      const bf16x8 fb1 = *(const bf16x8*)&Bs[(buf) * GBUF + (wn * 64 + 32 + r32) * LDT + ks * 16 + hi * 8]; \
      acc[0][0] = MFMA(fa0, fb0, acc[0][0]); acc[0][1] = MFMA(fa0, fb1, acc[0][1]); \
      acc[1][0] = MFMA(fa1, fb0, acc[1][0]); acc[1][1] = MFMA(fa1, fb1, acc[1][1]); } __builtin_amdgcn_s_setprio(0); } while (0)
  __builtin_amdgcn_s_setprio(0);
  BLOAD(a0, b0, 0); BLOAD(a1, b1, 1);
  __syncthreads();
  BSTORE(a0, b0, 0);
  BLOAD(a0, b0, 2);
  __syncthreads();
#pragma unroll
  for (int kt = 0; kt < nk; kt += 2) {
    BCOMP(0);
    BSTORE(a1, b1, 1);
    if (kt + 3 < nk) BLOAD(a1, b1, kt + 3);
    __syncthreads();
    BCOMP(1);
    if (kt + 2 < nk) { BSTORE(a0, b0, 0); if (kt + 4 < nk) BLOAD(a0, b0, kt + 4); }
    __syncthreads();
  }
#undef BLOAD
#undef BSTORE
#undef BCOMP
  if constexpr (ROWNORM) {
#pragma unroll
    for (int i = 0; i < 4; ++i) {
      float s = ss[i]; s += __shfl_xor(s, 1); s += __shfl_xor(s, 2); s += __shfl_xor(s, 4);
      if ((tid & 7) == 0) rinv_s[srow + 32 * i] = rsqrtf(s / (float)K + EPS);
    }
  }
}

struct RowSS { f32x4 a, b; };
DI RowSS rowss_load(const float* ps, int m0) { const int tid = TID(); const float* q = ps + (size_t)(m0 + (tid >> 1)) * 16 + (tid & 1) * 8; RowSS r; r.a = *(const f32x4*)q; r.b = *(const f32x4*)(q + 4); return r; }
DI void rowss_finish(const RowSS& r, float* rinv_s) {
  const int tid = TID();
  float s = (r.a[0] + r.a[1]) + (r.a[2] + r.a[3]) + (r.b[0] + r.b[1]) + (r.b[2] + r.b[3]);
  s += __shfl_xor(s, 1);
  if ((tid & 1) == 0) rinv_s[tid >> 1] = rsqrtf(s * (1.f / 1024.f) + EPS);
}

struct PF { u32x4 a0[4], b0[4], a1[4], b1[4]; };
DI void gemm_issue(PF& pf, const u16* __restrict__ Ap, int lda, const u16* __restrict__ Wt, int K) {
  const int tid = TID(); const int srow = tid >> 3, sc8 = (tid & 7) * 8;
  const unsigned aoff = (unsigned)(srow * lda + sc8) * 2u, woff = (unsigned)(srow * K + sc8) * 2u;
#pragma unroll
  for (int i = 0; i < 4; ++i) {
    pf.a0[i] = *(const u32x4*)((const char*)Ap + (aoff + (unsigned)(32 * i * lda) * 2u)); pf.b0[i] = *(const u32x4*)((const char*)Wt + (woff + (unsigned)(32 * i * K) * 2u));
  }
#pragma unroll
  for (int i = 0; i < 4; ++i) {
    pf.a1[i] = *(const u32x4*)((const char*)Ap + (aoff + (unsigned)(32 * i * lda + 64) * 2u)); pf.b1[i] = *(const u32x4*)((const char*)Wt + (woff + (unsigned)(32 * i * K + 64) * 2u));
  }
}
template <int NK>
DI void gemm_run(PF& pf, const u16* __restrict__ Ap, int lda, const u16* __restrict__ Wt, f32x16 (&acc)[2][2], char* smem) {
  constexpr int K = NK * 64;
  const int tid = TID(), lane = tid & 63, w = tid >> 6, wm = w >> 1, wn = w & 1, r32 = lane & 31, hi = lane >> 5;
  u16* As = (u16*)smem; u16* Bs = As + 128 * LDT;
  const int srow = tid >> 3, sc8 = (tid & 7) * 8;
  constexpr int nk = NK;
  const unsigned aoff = (unsigned)(srow * lda + sc8) * 2u, woff = (unsigned)(srow * K + sc8) * 2u;
#define BLOAD(A_, B_, kt) do { _Pragma("unroll") for (int i = 0; i < 4; ++i) { \
    A_[i] = *(const u32x4*)((const char*)Ap + (aoff + (unsigned)(32 * i * lda + (kt) * 64) * 2u)); B_[i] = *(const u32x4*)((const char*)Wt + (woff + (unsigned)(32 * i * K + (kt) * 64) * 2u)); } } while (0)
#define BSTORE(A_, B_, buf) do { _Pragma("unroll") for (int i = 0; i < 4; ++i) { \
    *(u32x4*)&As[(buf) * GBUF + (srow + 32 * i) * LDT + sc8] = A_[i]; \
    *(u32x4*)&Bs[(buf) * GBUF + (srow + 32 * i) * LDT + sc8] = B_[i]; } } while (0)
#define BCOMP(buf) do { __builtin_amdgcn_s_setprio(1); _Pragma("unroll") for (int ks = 0; ks < 4; ++ks) { \
      const bf16x8 fa0 = *(const bf16x8*)&As[(buf) * GBUF + (wm * 64 + r32) * LDT + ks * 16 + hi * 8]; \
      const bf16x8 fa1 = *(const bf16x8*)&As[(buf) * GBUF + (wm * 64 + 32 + r32) * LDT + ks * 16 + hi * 8]; \
      const bf16x8 fb0 = *(const bf16x8*)&Bs[(buf) * GBUF + (wn * 64 + r32) * LDT + ks * 16 + hi * 8]; \
      const bf16x8 fb1 = *(const bf16x8*)&Bs[(buf) * GBUF + (wn * 64 + 32 + r32) * LDT + ks * 16 + hi * 8]; \
      acc[0][0] = MFMA(fa0, fb0, acc[0][0]); acc[0][1] = MFMA(fa0, fb1, acc[0][1]); \
      acc[1][0] = MFMA(fa1, fb0, acc[1][0]); acc[1][1] = MFMA(fa1, fb1, acc[1][1]); } __builtin_amdgcn_s_setprio(0); } while (0)
  __builtin_amdgcn_s_setprio(0);
  __syncthreads();
  BSTORE(pf.a0, pf.b0, 0);
  BLOAD(pf.a0, pf.b0, 2);
  __syncthreads();
#pragma unroll
  for (int kt = 0; kt < nk; kt += 2) {
    BCOMP(0);
    BSTORE(pf.a1, pf.b1, 1);
    if (kt + 3 < nk) BLOAD(pf.a1, pf.b1, kt + 3);
    __syncthreads();
    BCOMP(1);
    if (kt + 2 < nk) { BSTORE(pf.a0, pf.b0, 0); if (kt + 4 < nk) BLOAD(pf.a0, pf.b0, kt + 4); }
    __syncthreads();
  }
#undef BLOAD
#undef BSTORE
#undef BCOMP
}

DI void zero_acc(f32x16 (&acc)[2][2]) {
#pragma unroll
  for (int a = 0; a < 2; ++a)
#pragma unroll
    for (int b = 0; b < 2; ++b)
#pragma unroll
      for (int r = 0; r < 16; ++r) acc[a][b][r] = 0.f;
}

DI void acc_to_cs(const f32x16 (&acc)[2][2], float* Cs) {
  __builtin_amdgcn_s_setprio(2);
  const int tid = TID(), lane = tid & 63, w = tid >> 6, wm = w >> 1, wn = w & 1, r32 = lane & 31, hi = lane >> 5;
#pragma unroll
  for (int mt = 0; mt < 2; ++mt)
#pragma unroll
    for (int nt = 0; nt < 2; ++nt)
#pragma unroll
      for (int r = 0; r < 16; ++r) Cs[(wm * 64 + mt * 32 + crow(r, hi)) * CSL + wn * 64 + nt * 32 + r32] = acc[mt][nt][r];
  __syncthreads();
}

DI void rope32(float (&x)[32], int pos) {
#pragma unroll
  for (int i = 0; i < 16; ++i) {
    const float inv = __builtin_amdgcn_exp2f(-(float)i * (0.0625f * 13.287712379549449f));
    const float ang = (float)pos * inv;
    float rev = ang * 0.15915494309189535f; rev = rev - floorf(rev);
    const float s = __builtin_amdgcn_sinf(rev), c = __builtin_amdgcn_cosf(rev);
    const float a = x[i], b = x[16 + i];
    x[i] = a * c - b * s; x[16 + i] = a * s + b * c;
  }
}

DI int colmap(int mode, int n) {
  if (mode == 1) return n < 5248 ? n : (n < 5280 ? 8832 + (n - 5248) : n - 32);
  if (mode == 2) return (n / 96) * 128 + (n % 96);
  return n;
}
DI void prep_tile(const float* __restrict__ W, int K, int N, const float* __restrict__ gain, u16* __restrict__ dst, int mode, int tile, char* smem) {
  float* Ts = (float*)smem;
  const int ntn = (N + 63) >> 6; const int kt = tile / ntn, nt = tile - kt * ntn; const int k0 = kt * 64, n0 = nt * 64;
  const int tid = TID(), tx = tid & 63, ty = tid >> 6;
  __syncthreads();
  {
    const int n = n0 + tx; float v[16], g[16];
#pragma unroll
    for (int kk = 0; kk < 16; ++kk) v[kk] = (n < N) ? W[(size_t)(k0 + kk * 4 + ty) * N + n] : 0.f;
#pragma unroll
    for (int kk = 0; kk < 16; ++kk) g[kk] = gain ? gain[k0 + kk * 4 + ty] : 1.f;
#pragma unroll
    for (int kk = 0; kk < 16; ++kk) Ts[tx * 65 + kk * 4 + ty] = v[kk] * g[kk];
  }
  __syncthreads();
#pragma unroll
  for (int i = 0; i < 2; ++i) {
    const int cid = tid + 256 * i, nl = cid >> 3, kc = cid & 7, n = n0 + nl;
    if (n < N) {
      float v[8];
#pragma unroll
      for (int j = 0; j < 8; ++j) v[j] = Ts[nl * 65 + kc * 8 + j];
      st8(dst + (size_t)colmap(mode, n) * K + k0 + kc * 8, v);
    }
  }
}

DI void phase_prep(const Params& p, char* smem) {
  u16* ws16 = (u16*)p.ws;
  for (int e = 0; e < 20; ++e) {
    const int l = e / 10, k = e % 10;
    const float* W; const float* gain = nullptr; u16* dst; int K, N, mode = 0;
    switch (k) {
      case 0: W = p.w_in + (size_t)l * 1024 * DIN; K = 1024; N = DIN; gain = p.mix_norm + l * 1024; dst = (u16*)(p.ws + OFF_WIN + l * SZ_WIN); mode = 1; break;
      case 1: W = p.w_mla_q_b + (size_t)l * 384 * 768; K = 384; N = 768; gain = p.mla_q_a_norm + l * 384; dst = (u16*)(p.ws + OFF_WQB + l * SZ_WQB); mode = 2; break;
      case 2: W = p.w_mla_kv_b + (size_t)l * 256 * 1024; K = 256; N = 1024; gain = p.mla_kv_a_norm + l * 256; dst = (u16*)(p.ws + OFF_WKVB + l * SZ_WKVB); break;
      case 3: W = p.w_mem_kv + (size_t)l * 1024 * 1024; K = 1024; N = 1024; gain = p.mem_norm + l * 1024; dst = (u16*)(p.ws + OFF_WMEM + l * SZ_WMEM); break;
      case 4: case 5: case 6: W = p.w_branch + (size_t)(l * 3 + (k - 4)) * 512 * 1024; K = 512; N = 1024; dst = (u16*)(p.ws + OFF_WBR + (l * 3 + (k - 4)) * SZ_WBR); break;
      case 7: W = p.w_out + (size_t)l * 1024 * 1024; K = 1024; N = 1024; dst = (u16*)(p.ws + OFF_WOUT + l * SZ_WOUT); break;
      case 8: W = p.w_ff1 + (size_t)l * 1024 * 4096; K = 1024; N = 4096; gain = p.ffn_norm + l * 1024; dst = (u16*)(p.ws + OFF_WFF1 + l * SZ_WFF1); break;
      default: W = p.w_ff2 + (size_t)l * 4096 * 1024; K = 4096; N = 1024; dst = (u16*)(p.ws + OFF_WFF2 + l * SZ_WFF2); break;
    }
    const int nt = (K >> 6) * ((N + 63) >> 6);
    for (int t = BID(); t < nt; t += gridDim.x) prep_tile(W, K, N, gain, dst, mode, t, smem);
  }
  (void)ws16;
  {
    float* gt = (float*)(p.ws + OFF_GAINS);
    for (int i = BID() * 256 + TID(); i < GN_TOTAL; i += gridDim.x * 256) {
      float v;
      if (i < GN_DK) v = p.dil_q_norm[i]; else if (i < GN_MQ) v = p.dil_k_norm[i - GN_DK]; else if (i < GN_MK) v = p.mla_q_norm[i - GN_MQ];
      else if (i < GN_MEMQ) v = p.mla_k_norm[i - GN_MK]; else if (i < GN_MEMK) v = p.mem_q_norm[i - GN_MEMQ]; else v = p.mem_k_norm[i - GN_MEMK];
      gt[i] = v;
    }
  }
  const u32x4 z = {0u, 0u, 0u, 0u};
  const int gtid = BID() * 256 + TID(), gsz = gridDim.x * 256;
  for (int l = 0; l < 2; ++l) {
    u16* d1 = (u16*)(p.ws + OFF_WIN + l * SZ_WIN) + (size_t)DIN * 1024;
    for (int i = gtid; i < 96 * 1024 / 8; i += gsz) *(u32x4*)(d1 + (size_t)i * 8) = z;
    u16* d2 = (u16*)(p.ws + OFF_WQB + l * SZ_WQB);
    for (int i = gtid; i < 8 * 32 * 384 / 8; i += gsz) {
      const int h = i / (32 * 48), rem = i - h * (32 * 48), rr = rem / 48, c8 = rem - rr * 48;
      *(u32x4*)(d2 + (size_t)(h * 128 + 96 + rr) * 384 + c8 * 8) = z;
    }
  }
}

DI void tile_memkv(const Params& p, int l, int tile, char* smem) {
  float* Cs = (float*)smem; float* rinv_s = (float*)(smem + SMEM_CS);
  const int mi = tile % 48, ni = tile / 48; const int m0 = mi * 128;
  const float* A = (m0 < 2048) ? p.mem_prompt + (size_t)m0 * 1024 : p.mem_sample + (size_t)(m0 - 2048) * 1024;
  const u16* Wt = (const u16*)(p.ws + OFF_WMEM + l * SZ_WMEM) + (size_t)ni * 128 * 1024;
  f32x16 acc[2][2]; zero_acc(acc);
  gemm_main<true, true>(A, 1024, Wt, 1024, acc, smem, rinv_s);
  acc_to_cs(acc, Cs);
  const int tid = TID();
  if (ni < 4) {
    const int row = tid >> 1, half = tid & 1; const float rinv = rinv_s[row];
    const float* gain = (const float*)(p.ws + OFF_GAINS) + GN_MEMK + l * 128;
    float ssq = 0.f; float v[8];
#pragma unroll
    for (int c8 = 0; c8 < 8; ++c8) { cs_ld8(Cs, row, half * 64 + c8 * 8, v);
#pragma unroll
      for (int j = 0; j < 8; ++j) ssq += v[j] * v[j]; }
    ssq *= rinv * rinv; ssq += __shfl_xor(ssq, 1);
    const float rn = rsqrtf(ssq * (1.f / 128.f) + EPS) * rinv;
    u16* dst = (u16*)(p.ws + OFF_KMEM + l * SZ_KMEM) + (size_t)(m0 + row) * 512 + ni * 128 + half * 64;
#pragma unroll
    for (int c8 = 0; c8 < 8; ++c8) { cs_ld8(Cs, row, half * 64 + c8 * 8, v);
#pragma unroll
      for (int j = 0; j < 8; ++j) v[j] = v[j] * rn * gain[half * 64 + c8 * 8 + j];
      st8(dst + c8 * 8, v); }
  } else {
    const int h = ni - 4, col = tid & 127, c0 = tid >> 7; const int b = m0 >> 8, pos0 = m0 & 255;
    u16* dstb = (u16*)(p.ws + OFF_VMEMT + l * SZ_KMEM) + ((size_t)(b * 4 + h) * 128 + col) * 256 + pos0;
#pragma unroll
    for (int i = 0; i < 8; ++i) {
      const int cid = c0 + 2 * i; float v[8];
#pragma unroll
      for (int j = 0; j < 8; ++j) { const int lrow = cid * 8 + j; v[j] = Cs[lrow * CSL + col] * rinv_s[lrow]; }
      st8(dstb + cid * 8, v);
    }
  }
}

DI void inproj_ptrs(const Params& p, int l, int tile, const u16*& Ap, const u16*& Wt) {
  const int mi = tile & (MTN - 1), nj = tile >> MTS; const int ni = (nj < 45) ? nj : 69;
  Ap = (const u16*)(p.ws + OFF_XB) + (size_t)(mi * 128) * 1024; Wt = (const u16*)(p.ws + OFF_WIN + l * SZ_WIN) + (size_t)ni * 128 * 1024;
}
DI void tile_inproj(const Params& p, int l, const Chunk& ck, int tile, int next, PF& pf, char* smem) {
  float* Cs = (float*)smem; float* rinv_s = (float*)(smem + SMEM_CS);
  const int mi = tile & (MTN - 1), nj = tile >> MTS; const int ni = (nj < 45) ? nj : 69; const int m0 = mi * 128;
  const u16* Ap; const u16* Wt; inproj_ptrs(p, l, tile, Ap, Wt);
  f32x16 acc[2][2]; zero_acc(acc);
  const RowSS rss = rowss_load((const float*)(p.ws + OFF_PSIN), m0);
  gemm_run<16>(pf, Ap, 1024, Wt, acc, smem);
  if (next >= 0) { const u16* An; const u16* Wn; inproj_ptrs(p, l, next, An, Wn); gemm_issue(pf, An, 1024, Wn, 1024); }
  rowss_finish(rss, rinv_s);
  acc_to_cs(acc, Cs);
  const int tid = TID(), row = tid >> 1, half = tid & 1;
  const int lt = m0 + row; const int S = ck.S; const int bl = lt >> ck.sshift, t = lt & (S - 1);
  const float rinv = rinv_s[row];
  float v[8];
  if (ni < 24 || (ni >= 41 && ni < 45)) {
    const float* gain; u16* dst; float scale;
    if (ni < 24) {
      const int g = (ni % 12) >> 2, h = ni & 3; const bool isq = ni < 12; const int dsh = 2 * g, d = 1 << dsh, Lg = S >> dsh;
      gain = (const float*)(p.ws + OFF_GAINS) + (isq ? GN_DQ : GN_DK) + ((l * 3 + g) * 4 + h) * 128;
      const int pp = (t & (d - 1)) * Lg + (t >> dsh);
      dst = (u16*)(p.ws + (isq ? OFF_QD : OFF_KD)) + ((size_t)(g * CT + bl * S + pp)) * 512 + h * 128 + half * 64;
      scale = isq ? QS128 : 1.f;
    } else {
      const int h = ni - 41; gain = (const float*)(p.ws + OFF_GAINS) + GN_MEMQ + l * 128;
      dst = (u16*)(p.ws + OFF_MQ) + (size_t)lt * 512 + h * 128 + half * 64; scale = QS128;
    }
    float ssq = 0.f;
#pragma unroll
    for (int c8 = 0; c8 < 8; ++c8) { cs_ld8(Cs, row, half * 64 + c8 * 8, v);
#pragma unroll
      for (int j = 0; j < 8; ++j) ssq += v[j] * v[j]; }
    ssq *= rinv * rinv; ssq += __shfl_xor(ssq, 1);
    const float rn = rsqrtf(ssq * (1.f / 128.f) + EPS) * rinv * scale;
#pragma unroll
    for (int c8 = 0; c8 < 8; ++c8) { cs_ld8(Cs, row, half * 64 + c8 * 8, v);
#pragma unroll
      for (int j = 0; j < 8; ++j) v[j] = v[j] * rn * gain[half * 64 + c8 * 8 + j];
      st8(dst + c8 * 8, v); }
  } else if (ni < 36) {
    const int g = (ni - 24) >> 2, h = (ni - 24) & 3; const int dsh = 2 * g, d = 1 << dsh, Lg = S >> dsh;
    const int col = tid & 127, c0 = tid >> 7; const int blk = m0 >> ck.sshift, t0 = m0 & (S - 1), ub = t0 >> dsh;
    u16* dstb = (u16*)(p.ws + OFF_VDT) + ((size_t)((g * ck.nb + blk) * 4 + h) * 128 + col) * S;
#pragma unroll
    for (int i = 0; i < 8; ++i) {
      const int cid = c0 + 2 * i, r = cid & (d - 1), uc = cid >> dsh;
#pragma unroll
      for (int j = 0; j < 8; ++j) { const int lrow = ((uc * 8 + j) << dsh) + r; v[j] = Cs[lrow * CSL + col] * rinv_s[lrow]; }
      st8(dstb + r * Lg + ub + uc * 8, v);
    }
  } else if (ni < 41) {
    u16* dst = (ni < 39) ? (u16*)(p.ws + OFF_CQ) + (size_t)lt * 384 + (ni - 36) * 128 + half * 64 : (u16*)(p.ws + OFF_CKV) + (size_t)lt * 256 + (ni - 39) * 128 + half * 64;
#pragma unroll
    for (int c8 = 0; c8 < 8; ++c8) { cs_ld8(Cs, row, half * 64 + c8 * 8, v);
#pragma unroll
      for (int j = 0; j < 8; ++j) v[j] *= rinv;
      st8(dst + c8 * 8, v); }
  } else {
    if (half == 0) {
      u16* dst = (u16*)(p.ws + OFF_KR) + (size_t)lt * 32;
#pragma unroll
      for (int c8 = 0; c8 < 4; ++c8) { cs_ld8(Cs, row, c8 * 8, v);
#pragma unroll
        for (int j = 0; j < 8; ++j) v[j] *= rinv;
        st8(dst + c8 * 8, v); }
    }
  }
}

DI void tile_mla_up(const Params& p, int l, const Chunk& ck, int tile, char* smem) {
  float* Cs = (float*)smem; float* rinv_s = (float*)(smem + SMEM_CS);
  const int mi = tile & (MTN - 1), ni = tile >> MTS; const int m0 = mi * 128;
  const int tid = TID(), row = tid >> 1, half = tid & 1;
  const int lt = m0 + row; const int S = ck.S; const int t = lt & (S - 1);
  f32x16 acc[2][2]; zero_acc(acc);
  float v[8];
  if (ni < 8) {
    const int h = ni;
    gemm_main_bf<true, 6>((const u16*)(p.ws + OFF_CQ) + (size_t)m0 * 384, 384, (const u16*)(p.ws + OFF_WQB + l * SZ_WQB) + (size_t)h * 128 * 384, acc, smem, rinv_s);
    acc_to_cs(acc, Cs);
    const float rinv = rinv_s[row]; const float* gain = (const float*)(p.ws + OFF_GAINS) + GN_MQ + l * 96;
    float ssq = 0.f;
    if (half == 0) {
#pragma unroll
      for (int c8 = 0; c8 < 8; ++c8) { cs_ld8(Cs, row, c8 * 8, v);
#pragma unroll
        for (int j = 0; j < 8; ++j) ssq += v[j] * v[j]; }
    } else {
#pragma unroll
      for (int c8 = 0; c8 < 4; ++c8) { cs_ld8(Cs, row, 64 + c8 * 8, v);
#pragma unroll
        for (int j = 0; j < 8; ++j) ssq += v[j] * v[j]; }
    }
    ssq *= rinv * rinv; ssq += __shfl_xor(ssq, 1);
    const float rn = rsqrtf(ssq * (1.f / 96.f) + EPS) * rinv * QS96;
    u16* dst = (u16*)(p.ws + OFF_QM) + (size_t)lt * 768 + h * 96;
    if (half == 0) {
#pragma unroll
      for (int c8 = 0; c8 < 8; ++c8) { cs_ld8(Cs, row, c8 * 8, v);
#pragma unroll
        for (int j = 0; j < 8; ++j) v[j] = v[j] * rn * gain[c8 * 8 + j];
        st8(dst + c8 * 8, v); }
    } else {
      float x[32];
#pragma unroll
      for (int c8 = 0; c8 < 4; ++c8) { cs_ld8(Cs, row, 64 + c8 * 8, v);
#pragma unroll
        for (int j = 0; j < 8; ++j) x[c8 * 8 + j] = v[j] * rn * gain[64 + c8 * 8 + j]; }
      rope32(x, t);
#pragma unroll
      for (int c8 = 0; c8 < 4; ++c8) {
#pragma unroll
        for (int j = 0; j < 8; ++j) v[j] = x[c8 * 8 + j];
        st8(dst + 64 + c8 * 8, v); }
    }
  } else {
    const int h = ni - 8;
    gemm_main_bf<true, 4>((const u16*)(p.ws + OFF_CKV) + (size_t)m0 * 256, 256, (const u16*)(p.ws + OFF_WKVB + l * SZ_WKVB) + (size_t)h * 128 * 256, acc, smem, rinv_s);
    acc_to_cs(acc, Cs);
    const float rinv = rinv_s[row]; const float* gain = (const float*)(p.ws + OFF_GAINS) + GN_MK + l * 96;
    float ssq = 0.f; float x[32];
    if (half == 0) {
#pragma unroll
      for (int c8 = 0; c8 < 8; ++c8) { cs_ld8(Cs, row, c8 * 8, v);
#pragma unroll
        for (int j = 0; j < 8; ++j) ssq += v[j] * v[j]; }
      ssq *= rinv * rinv;
    } else {
      const u16* kr = (const u16*)(p.ws + OFF_KR) + (size_t)lt * 32;
#pragma unroll
      for (int c8 = 0; c8 < 4; ++c8) { const u32x4 u = *(const u32x4*)(kr + c8 * 8); unpack8(u, v);
#pragma unroll
        for (int j = 0; j < 8; ++j) { x[c8 * 8 + j] = v[j]; ssq += v[j] * v[j]; } }
    }
    ssq += __shfl_xor(ssq, 1);
    const float rn = rsqrtf(ssq * (1.f / 96.f) + EPS);
    u16* dst = (u16*)(p.ws + OFF_KM) + (size_t)lt * 768 + h * 96;
    if (half == 0) {
      const float rr = rn * rinv;
#pragma unroll
      for (int c8 = 0; c8 < 8; ++c8) { cs_ld8(Cs, row, c8 * 8, v);
#pragma unroll
        for (int j = 0; j < 8; ++j) v[j] = v[j] * rr * gain[c8 * 8 + j];
        st8(dst + c8 * 8, v); }
    } else {
#pragma unroll
      for (int e = 0; e < 32; ++e) x[e] = x[e] * rn * gain[64 + e];
      rope32(x, t);
#pragma unroll
      for (int c8 = 0; c8 < 4; ++c8) {
#pragma unroll
        for (int j = 0; j < 8; ++j) v[j] = x[c8 * 8 + j];
        st8(dst + 64 + c8 * 8, v); }
    }
    const int col = tid & 63, c0 = tid >> 6; const int blk = m0 >> ck.sshift, t0 = m0 & (S - 1);
    u16* dstb = (u16*)(p.ws + OFF_VMT) + ((size_t)(blk * 8 + h) * 64 + col) * S + t0;
#pragma unroll
    for (int i = 0; i < 4; ++i) {
      const int cid = c0 + 4 * i;
#pragma unroll
      for (int j = 0; j < 8; ++j) { const int lrow = cid * 8 + j; v[j] = Cs[lrow * CSL + 64 + col] * rinv_s[lrow]; }
      st8(dstb + cid * 8, v);
    }
  }
}

DI float xhalf_max(float x) { const auto rr = __builtin_amdgcn_permlane32_swap(__float_as_uint(x), __float_as_uint(x), false, false); return fmaxf(__uint_as_float(rr[0]), __uint_as_float(rr[1])); }
DI float xhalf_sum(float x) { const auto rr = __builtin_amdgcn_permlane32_swap(__float_as_uint(x), __float_as_uint(x), false, false); return __uint_as_float(rr[0]) + __uint_as_float(rr[1]); }

template <int DQK, int DV, bool BAND>
DI void attn_block(const u16* __restrict__ Q, int ldq, const u16* __restrict__ Kp, int ldk, const u16* __restrict__ Vt, int ldv,
                   int nkeys, int q0, float bias_step, u16* __restrict__ O, int ostride, float* __restrict__ LSE, int lsestride, char* smem) {
  constexpr int KLD = DQK + 8, VLD = 68, ND0 = DQK / 16, NCB = DV / 32;
  constexpr int KCPR = DQK / 8, KCH = 64 * KCPR / 256, VCH = DV * 8 / 256;
  const int tid = TID(), lane = tid & 63, w = tid >> 6, r32 = lane & 31, hi = lane >> 5;
  u16* Ks = (u16*)smem; u16* Vs = (u16*)(smem + 17408); float* sc = (float*)(smem + 34816) + w * 64;
  const int qw0 = q0 + w * 32, qi = qw0 + r32;
  bf16x8 qf[ND0];
#pragma unroll
  for (int d0 = 0; d0 < ND0; ++d0) qf[d0] = *(const bf16x8*)(Q + (size_t)(w * 32 + r32) * ldq + d0 * 16 + hi * 8);
  f32x16 o[NCB];
#pragma unroll
  for (int cb = 0; cb < NCB; ++cb)
#pragma unroll
    for (int r = 0; r < 16; ++r) o[cb][r] = 0.f;
  float m_run = -INFINITY, l_run = 0.f;
  int kt_lo = 0, kt_hi = nkeys >> 6;
  if (BAND) { kt_lo = max(0, (q0 >> 6) - 1); kt_hi = min(nkeys >> 6, (q0 >> 6) + 3); }
  u32x4 kreg[KCH], vreg[VCH];
#define ALOAD(kt) do { \
    _Pragma("unroll") for (int i = 0; i < KCH; ++i) { const int cid = tid + 256 * i, row = cid / KCPR, c8 = cid - row * KCPR; kreg[i] = *(const u32x4*)(Kp + (size_t)((kt) * 64 + row) * ldk + c8 * 8); } \
    _Pragma("unroll") for (int i = 0; i < VCH; ++i) { const int cid = tid + 256 * i, row = cid >> 3, c8 = cid & 7; vreg[i] = *(const u32x4*)(Vt + (size_t)row * ldv + (kt) * 64 + c8 * 8); } } while (0)
  constexpr bool PREF = true;
  if (PREF) ALOAD(kt_lo);
  for (int kt = kt_lo; kt < kt_hi; ++kt) {
    __syncthreads();
    if (!PREF) ALOAD(kt);
#pragma unroll
    for (int i = 0; i < KCH; ++i) { const int cid = tid + 256 * i, row = cid / KCPR, c8 = cid - row * KCPR; *(u32x4*)&Ks[row * KLD + c8 * 8] = kreg[i]; }
#pragma unroll
    for (int i = 0; i < VCH; ++i) { const int cid = tid + 256 * i, row = cid >> 3, c8 = cid & 7;
      *(u32x2*)&Vs[row * VLD + c8 * 8] = u32x2{vreg[i][0], vreg[i][1]}; *(u32x2*)&Vs[row * VLD + c8 * 8 + 4] = u32x2{vreg[i][2], vreg[i][3]}; }
    __syncthreads();
    if (PREF && kt + 1 < kt_hi) ALOAD(kt + 1);
    if constexpr (DQK < 128) {
      f32x16 p0, p1;
#pragma unroll
      for (int r = 0; r < 16; ++r) { p0[r] = 0.f; p1[r] = 0.f; }
      __builtin_amdgcn_s_setprio(1);
#pragma unroll
      for (int d0 = 0; d0 < ND0; ++d0) {
        const bf16x8 k0f = *(const bf16x8*)&Ks[r32 * KLD + d0 * 16 + hi * 8];
        const bf16x8 k1f = *(const bf16x8*)&Ks[(32 + r32) * KLD + d0 * 16 + hi * 8];
        p0 = MFMA(k0f, qf[d0], p0); p1 = MFMA(k1f, qf[d0], p1);
      }
      __builtin_amdgcn_s_setprio(0);
      float mx = fmaxf(p0[0], p1[0]);
#pragma unroll
      for (int r = 1; r < 16; ++r) mx = fmaxf(mx, fmaxf(p0[r], p1[r]));
      mx = xhalf_max(mx);
      if (__builtin_amdgcn_ballot_w64(mx > m_run + 8.f) != 0ull) {
        const float m_new = fmaxf(m_run, mx); const float m_use = (m_new == -INFINITY) ? 0.f : m_new;
        const float alpha = __builtin_amdgcn_exp2f(m_run - m_use);
        l_run *= alpha; m_run = m_new;
        if (hi == 0) sc[r32] = alpha;
        __builtin_amdgcn_fence(__ATOMIC_RELEASE, "wavefront");
        __builtin_amdgcn_wave_barrier();
#pragma unroll
        for (int g4 = 0; g4 < 4; ++g4) { const f32x4 a4 = *(const f32x4*)&sc[8 * g4 + 4 * hi];
#pragma unroll
          for (int cb = 0; cb < NCB; ++cb)
#pragma unroll
            for (int j = 0; j < 4; ++j) o[cb][4 * g4 + j] *= a4[j]; }
        __builtin_amdgcn_wave_barrier();
      }
      const float m_ref = (m_run == -INFINITY) ? 0.f : m_run;
      float rs0 = 0.f, rs1 = 0.f;
#pragma unroll
      for (int r = 0; r < 16; ++r) { const float e0 = __builtin_amdgcn_exp2f(p0[r] - m_ref), e1 = __builtin_amdgcn_exp2f(p1[r] - m_ref); p0[r] = e0; p1[r] = e1; rs0 += e0; rs1 += e1; }
      l_run += xhalf_sum(rs0 + rs1);
      __builtin_amdgcn_s_setprio(1);
#pragma unroll
      for (int s = 0; s < 2; ++s) {
        const u32x4 pu0 = {pk2(p0[8 * s], p0[8 * s + 1]), pk2(p0[8 * s + 2], p0[8 * s + 3]), pk2(p0[8 * s + 4], p0[8 * s + 5]), pk2(p0[8 * s + 6], p0[8 * s + 7])};
        const u32x4 pu1 = {pk2(p1[8 * s], p1[8 * s + 1]), pk2(p1[8 * s + 2], p1[8 * s + 3]), pk2(p1[8 * s + 4], p1[8 * s + 5]), pk2(p1[8 * s + 6], p1[8 * s + 7])};
#pragma unroll
        for (int cb = 0; cb < NCB; ++cb) {
          const u32x2 lo0 = *(const u32x2*)&Vs[(cb * 32 + r32) * VLD + 16 * s + 4 * hi];
          const u32x2 hi0 = *(const u32x2*)&Vs[(cb * 32 + r32) * VLD + 16 * s + 4 * hi + 8];
          const u32x4 v0 = {lo0[0], lo0[1], hi0[0], hi0[1]};
          o[cb] = MFMA(__builtin_bit_cast(bf16x8, pu0), __builtin_bit_cast(bf16x8, v0), o[cb]);
        }
#pragma unroll
        for (int cb = 0; cb < NCB; ++cb) {
          const u32x2 lo1 = *(const u32x2*)&Vs[(cb * 32 + r32) * VLD + 32 + 16 * s + 4 * hi];
          const u32x2 hi1 = *(const u32x2*)&Vs[(cb * 32 + r32) * VLD + 32 + 16 * s + 4 * hi + 8];
          const u32x4 v1 = {lo1[0], lo1[1], hi1[0], hi1[1]};
          o[cb] = MFMA(__builtin_bit_cast(bf16x8, pu1), __builtin_bit_cast(bf16x8, v1), o[cb]);
        }
      }
      __builtin_amdgcn_s_setprio(0);
    } else
#pragma unroll 1
    for (int sub = 0; sub < 2; ++sub) {
      const int k0 = kt * 64 + sub * 32;
      if (BAND) { if (k0 > qw0 + 95 || k0 + 31 < qw0 - 64) continue; }
      f32x16 pacc;
#pragma unroll
      for (int r = 0; r < 16; ++r) pacc[r] = 0.f;
#pragma unroll
      for (int d0 = 0; d0 < ND0; ++d0) { const bf16x8 kf = *(const bf16x8*)&Ks[(sub * 32 + r32) * KLD + d0 * 16 + hi * 8]; pacc = MFMA(kf, qf[d0], pacc); }
      float mx = -INFINITY;
      if (BAND) {
#pragma unroll
        for (int r = 0; r < 16; ++r) { const int rel = k0 + crow(r, hi) - qi; const int a = rel < 0 ? -rel : rel;
          const float s = (a <= 64) ? pacc[r] - bias_step * (float)a : -INFINITY; pacc[r] = s; mx = fmaxf(mx, s); }
      } else {
#pragma unroll
        for (int r = 0; r < 16; ++r) mx = fmaxf(mx, pacc[r]);
      }
      mx = xhalf_max(mx);
      if (__builtin_amdgcn_ballot_w64(mx > m_run + 8.f) != 0ull) {
        const float m_new = fmaxf(m_run, mx); const float m_use = (m_new == -INFINITY) ? 0.f : m_new;
        const float alpha = __builtin_amdgcn_exp2f(m_run - m_use);
        l_run *= alpha; m_run = m_new;
        if (hi == 0) sc[r32] = alpha;
        __builtin_amdgcn_fence(__ATOMIC_RELEASE, "wavefront");
        __builtin_amdgcn_wave_barrier();
#pragma unroll
        for (int g4 = 0; g4 < 4; ++g4) { const f32x4 a4 = *(const f32x4*)&sc[8 * g4 + 4 * hi];
#pragma unroll
          for (int cb = 0; cb < NCB; ++cb)
#pragma unroll
            for (int j = 0; j < 4; ++j) o[cb][4 * g4 + j] *= a4[j]; }
        __builtin_amdgcn_wave_barrier();
      }
      const float m_ref = (m_run == -INFINITY) ? 0.f : m_run;
      float rs = 0.f;
#pragma unroll
      for (int r = 0; r < 16; ++r) { const float pe = __builtin_amdgcn_exp2f(pacc[r] - m_ref); pacc[r] = pe; rs += pe; }
      l_run += xhalf_sum(rs);
#pragma unroll
      for (int s = 0; s < 2; ++s) {
        const u32x4 pu = {pk2(pacc[8 * s], pacc[8 * s + 1]), pk2(pacc[8 * s + 2], pacc[8 * s + 3]), pk2(pacc[8 * s + 4], pacc[8 * s + 5]), pk2(pacc[8 * s + 6], pacc[8 * s + 7])};
        const bf16x8 pa = __builtin_bit_cast(bf16x8, pu);
#pragma unroll
        for (int cb = 0; cb < NCB; ++cb) {
          const u32x2 lo = *(const u32x2*)&Vs[(cb * 32 + r32) * VLD + sub * 32 + 16 * s + 4 * hi];
          const u32x2 h8 = *(const u32x2*)&Vs[(cb * 32 + r32) * VLD + sub * 32 + 16 * s + 4 * hi + 8];
          const u32x4 vu = {lo[0], lo[1], h8[0], h8[1]};
          o[cb] = MFMA(pa, __builtin_bit_cast(bf16x8, vu), o[cb]);
        }
      }
    }
  }
#undef ALOAD
  if (hi == 0) sc[32 + r32] = l_run;
  __builtin_amdgcn_fence(__ATOMIC_RELEASE, "wavefront");
  __builtin_amdgcn_wave_barrier();
#pragma unroll
  for (int g4 = 0; g4 < 4; ++g4) {
    const f32x4 l4 = *(const f32x4*)&sc[32 + 8 * g4 + 4 * hi];
#pragma unroll
    for (int j = 0; j < 4; ++j) {
      const float inv = 1.f / l4[j]; const int r = 4 * g4 + j; const int qrow = w * 32 + crow(r, hi);
#pragma unroll
      for (int cb = 0; cb < NCB; ++cb) {
        const unsigned pb = pk2(o[cb][r] * inv, 0.f);
        O[(size_t)qrow * ostride + cb * 32 + r32] = (u16)(pb & 0xffffu);
      }
    }
  }
  __builtin_amdgcn_wave_barrier();
  if (LSE != nullptr && hi == 0) LSE[(size_t)(w * 32 + r32) * lsestride] = (m_run + __builtin_amdgcn_logf(l_run)) * LN2;
}

DI void item_attn(const Params& p, int l, const Chunk& ck, int it, char* smem) {
  const int S = ck.S;
  if (it < 8 * MTN) {
    static_assert(8 * MTN == 1024, "MLA item swizzle assumes 1024 items");
    const int rnd = it >> 9, x = it & 7, jj = (it & 511) >> 3; const int qs = ck.sshift - 7, ppx = 64 >> qs;
    const int bh = rnd * (8 * ppx) + x * ppx + (jj >> qs), qblk = jj & ((1 << qs) - 1);
    const int h = bh & 7, bl = bh >> 3; const int t0 = qblk * 128, lt0 = bl * S + t0;
    const u16* Q = (const u16*)(p.ws + OFF_QM) + (size_t)lt0 * 768 + h * 96;
    const u16* K = (const u16*)(p.ws + OFF_KM) + (size_t)(bl * S) * 768 + h * 96;
    const u16* Vt = (const u16*)(p.ws + OFF_VMT) + ((size_t)(bl * 8 + h) * 64) * S;
    u16* O = (u16*)(p.ws + OFF_BR) + (size_t)(1 * CT + lt0) * 512 + h * 64;
    (void)t0;
    attn_block<96, 64, false>(Q, 768, K, 768, Vt, S, S, t0, 0.f, O, 512, nullptr, 0, smem);
  } else if (it < 20 * MTN) {
    const int j = it - 8 * MTN; const int x = j & 7, kk = j >> 3; const int qb = x * 16 + (kk & 15), gh = kk >> 4; const int g = gh >> 2, h = gh & 3;
    const int dsh = 2 * g, d = 1 << dsh, Lg = S >> dsh;
    const int prow0 = qb * 128; const int bl = prow0 >> ck.sshift, pp0 = prow0 & (S - 1); const int r = pp0 / Lg, u0 = pp0 - r * Lg;
    const u16* Q = (const u16*)(p.ws + OFF_QD) + ((size_t)(g * CT + bl * S + r * Lg + u0)) * 512 + h * 128;
    const u16* K = (const u16*)(p.ws + OFF_KD) + ((size_t)(g * CT + bl * S + r * Lg)) * 512 + h * 128;
    const u16* Vt = (const u16*)(p.ws + OFF_VDT) + ((size_t)((g * ck.nb + bl) * 4 + h) * 128) * S + r * Lg;
    const float slope = __builtin_amdgcn_exp2f(-8.f * (float)(g * 4 + h + 1) / 12.f);
    const size_t tokrow = (size_t)g * CT + bl * S + (size_t)u0 * d + r;
    u16* O = (u16*)(p.ws + OFF_AO) + tokrow * 512 + h * 128;
    float* LSE = (float*)(p.ws + OFF_LSE) + tokrow * 4 + h;
    attn_block<128, 128, true>(Q, 512, K, 512, Vt, S, Lg, u0, slope * (float)d * LOG2E, O, d * 512, LSE, d * 4, smem);
  } else {
    const int j = it - 20 * MTN; const int x = j & 7, kk = j >> 3; const int qb = x * 16 + (kk & 15), h = kk >> 4; const int lt0 = qb * 128; const int bl = lt0 >> ck.sshift;
    const int gb = ck.mb0 + bl;
    const u16* Q = (const u16*)(p.ws + OFF_MQ) + (size_t)lt0 * 512 + h * 128;
    const u16* K = (const u16*)(p.ws + OFF_KMEM + l * SZ_KMEM) + (size_t)(gb * 256) * 512 + h * 128;
    const u16* Vt = (const u16*)(p.ws + OFF_VMEMT + l * SZ_KMEM) + ((size_t)(gb * 4 + h) * 128) * 256;
    u16* O = (u16*)(p.ws + OFF_BR) + (size_t)(2 * CT + lt0) * 512 + h * 128;
    attn_block<128, 128, false>(Q, 512, K, 512, Vt, 256, 256, 0, 0.f, O, 512, nullptr, 0, smem);
  }
}

DI void phase_merge(const Params& p) {
  const int gsz = gridDim.x * 256;
  const u16* AO = (const u16*)(p.ws + OFF_AO); const float* LSE = (const float*)(p.ws + OFF_LSE); u16* BR0 = (u16*)(p.ws + OFF_BR);
  constexpr int U = 4;
  for (int i0 = BID() * 256 + TID(); i0 < CT * 64; i0 += gsz * U) {
    float l0[U], l1[U], l2[U]; u32x4 ra[U], rb[U], rc[U];
#pragma unroll
    for (int u = 0; u < U; ++u) {
      const int i = i0 + u * gsz; const bool ok = i < CT * 64; const int ii = ok ? i : i0;
      const int lt = ii >> 6, c8 = ii & 63, h = c8 >> 4;
      l0[u] = LSE[(size_t)(0 * CT + lt) * 4 + h]; l1[u] = LSE[(size_t)(1 * CT + lt) * 4 + h]; l2[u] = LSE[(size_t)(2 * CT + lt) * 4 + h];
      ra[u] = *(const u32x4*)(AO + (size_t)(0 * CT + lt) * 512 + c8 * 8);
      rb[u] = *(const u32x4*)(AO + (size_t)(1 * CT + lt) * 512 + c8 * 8);
      rc[u] = *(const u32x4*)(AO + (size_t)(2 * CT + lt) * 512 + c8 * 8);
    }
#pragma unroll
    for (int u = 0; u < U; ++u) {
      const int i = i0 + u * gsz; if (i >= CT * 64) break;
      const int lt = i >> 6, c8 = i & 63;
      const float mx = fmaxf(l0[u], fmaxf(l1[u], l2[u]));
      float w0 = __expf(l0[u] - mx), w1 = __expf(l1[u] - mx), w2 = __expf(l2[u] - mx); const float inv = 1.f / (w0 + w1 + w2); w0 *= inv; w1 *= inv; w2 *= inv;
      float a[8], b[8], c[8], o[8];
      unpack8(ra[u], a); unpack8(rb[u], b); unpack8(rc[u], c);
#pragma unroll
      for (int j = 0; j < 8; ++j) o[j] = w0 * a[j] + w1 * b[j] + w2 * c[j];
      st8(BR0 + (size_t)lt * 512 + c8 * 8, o);
    }
  }
}

DI void tile_branch(const Params& p, int l, int tile, char* smem) {
  float* Cs = (float*)smem;
  const int tid = TID(), lane = tid & 63, w = tid >> 6, wm = w >> 1, wn = w & 1, r32 = lane & 31, hi = lane >> 5;
  const int mi = tile & (MTN - 1), ni = tile >> MTS; const int m0 = mi * 128, n0 = ni * 128;
  unsigned upk[2][2][8];
#pragma unroll
  for (int a = 0; a < 2; ++a)
#pragma unroll
    for (int b = 0; b < 2; ++b)
#pragma unroll
      for (int i = 0; i < 8; ++i) upk[a][b][i] = 0u;
  float* rinv_s = (float*)(smem + SMEM_CS);
  { const RowSS rss = rowss_load((const float*)(p.ws + OFF_PSIN), m0); rowss_finish(rss, rinv_s); }
#pragma unroll 1
  for (int br = 0; br < 3; ++br) {
    unsigned gpk[2][2][8];
    {
      f32x16 accg[2][2]; zero_acc(accg);
      gemm_main_bf<false, 16>((const u16*)(p.ws + OFF_XB) + (size_t)m0 * 1024, 1024,
                              (const u16*)(p.ws + OFF_WIN + l * SZ_WIN) + (size_t)(5760 + br * 1024 + n0) * 1024, accg, smem, nullptr);
      __syncthreads();
#pragma unroll
      for (int mt = 0; mt < 2; ++mt)
#pragma unroll
        for (int g4 = 0; g4 < 4; ++g4) {
          const f32x4 r4 = *(const f32x4*)&rinv_s[wm * 64 + mt * 32 + 8 * g4 + 4 * hi];
#pragma unroll
          for (int nt = 0; nt < 2; ++nt) {
            const float s0 = 1.f / (1.f + __expf(-accg[mt][nt][4 * g4 + 0] * r4[0])), s1 = 1.f / (1.f + __expf(-accg[mt][nt][4 * g4 + 1] * r4[1]));
            const float s2 = 1.f / (1.f + __expf(-accg[mt][nt][4 * g4 + 2] * r4[2])), s3 = 1.f / (1.f + __expf(-accg[mt][nt][4 * g4 + 3] * r4[3]));
            gpk[mt][nt][2 * g4] = pk2(s0, s1); gpk[mt][nt][2 * g4 + 1] = pk2(s2, s3);
          }
        }
    }
    f32x16 acc[2][2]; zero_acc(acc);
    gemm_main_bf<false, 8>((const u16*)(p.ws + OFF_BR) + (size_t)(br * CT + m0) * 512, 512,
                            (const u16*)(p.ws + OFF_WBR + (l * 3 + br) * SZ_WBR) + (size_t)n0 * 512, acc, smem, nullptr);
#pragma unroll
    for (int mt = 0; mt < 2; ++mt)
#pragma unroll
      for (int nt = 0; nt < 2; ++nt)
#pragma unroll
        for (int i = 0; i < 8; ++i) {
          const float g0 = __uint_as_float(gpk[mt][nt][i] << 16), g1 = __uint_as_float(gpk[mt][nt][i] & 0xffff0000u);
          const float a = __uint_as_float(upk[mt][nt][i] << 16) + g0 * acc[mt][nt][2 * i];
          const float b = __uint_as_float(upk[mt][nt][i] & 0xffff0000u) + g1 * acc[mt][nt][2 * i + 1];
          upk[mt][nt][i] = pk2(a, b);
        }
  }
  __syncthreads();
#pragma unroll
  for (int mt = 0; mt < 2; ++mt)
#pragma unroll
    for (int nt = 0; nt < 2; ++nt)
#pragma unroll
      for (int i = 0; i < 8; ++i) {
        const int cc = wn * 64 + nt * 32 + r32;
        Cs[(wm * 64 + mt * 32 + crow(2 * i, hi)) * CSL + cc] = __uint_as_float(upk[mt][nt][i] << 16);
        Cs[(wm * 64 + mt * 32 + crow(2 * i + 1, hi)) * CSL + cc] = __uint_as_float(upk[mt][nt][i] & 0xffff0000u);
      }
  __syncthreads();
  const int row = tid >> 1, half = tid & 1; float v[8];
  u16* dst = (u16*)(p.ws + OFF_U) + (size_t)(m0 + row) * 1024 + n0 + half * 64;
#pragma unroll
  for (int c8 = 0; c8 < 8; ++c8) { cs_ld8(Cs, row, half * 64 + c8 * 8, v); st8(dst + c8 * 8, v); }
}

DI void outproj_ptrs(const Params& p, int l, int tile, const u16*& Ap, const u16*& Wt) {
  const int mi = tile & (MTN - 1), ni = tile >> MTS;
  Ap = (const u16*)(p.ws + OFF_U) + (size_t)(mi * 128) * 1024; Wt = (const u16*)(p.ws + OFF_WOUT + l * SZ_WOUT) + (size_t)(ni * 128) * 1024;
}
DI void tile_outproj(const Params& p, int l, const Chunk& ck, int tile, int next, PF& pf, char* smem) {
  float* Cs = (float*)smem;
  const int tid = TID(); const int mi = tile & (MTN - 1), ni = tile >> MTS; const int m0 = mi * 128, n0 = ni * 128;
  f32x16 acc[2][2]; zero_acc(acc);
  { const u16* Ap; const u16* Wt; outproj_ptrs(p, l, tile, Ap, Wt); gemm_run<16>(pf, Ap, 1024, Wt, acc, smem); }
  if (next >= 0) { const u16* An; const u16* Wn; outproj_ptrs(p, l, next, An, Wn); gemm_issue(pf, An, 1024, Wn, 1024); }
  acc_to_cs(acc, Cs);
  const int row = tid >> 1, half = tid & 1; float ssq = 0.f;
  u16* xb = (u16*)(p.ws + OFF_XB) + (size_t)(m0 + row) * 1024 + n0 + half * 64;
#pragma unroll
  for (int c8 = 0; c8 < 8; ++c8) {
    float v[8], x[8]; cs_ld8(Cs, row, half * 64 + c8 * 8, v); unpack8(*(const u32x4*)(xb + c8 * 8), x);
#pragma unroll
    for (int j = 0; j < 8; ++j) { v[j] += x[j]; ssq += v[j] * v[j]; }
    *(u32x4*)(xb + c8 * 8) = pack8(v);
  }
  ((float*)(p.ws + OFF_PSMID))[(size_t)(m0 + row) * 16 + ni * 2 + half] = ssq;
}

DI void ffn1_ptrs(const Params& p, int l, int tile, const u16*& Ap, const u16*& Wt) {
  const int mi = tile & (MTN - 1), ni = tile >> MTS;
  Ap = (const u16*)(p.ws + OFF_XB) + (size_t)(mi * 128) * 1024; Wt = (const u16*)(p.ws + OFF_WFF1 + l * SZ_WFF1) + (size_t)(ni * 128) * 1024;
}
DI void tile_ffn1(const Params& p, int l, const Chunk& ck, int tile, int next, PF& pf, char* smem) {
  float* Cs = (float*)smem; float* rinv_s = (float*)(smem + SMEM_CS);
  const int tid = TID(); const int mi = tile & (MTN - 1), ni = tile >> MTS; const int m0 = mi * 128, n0 = ni * 128;
  f32x16 acc[2][2]; zero_acc(acc);
  const RowSS rss = rowss_load((const float*)(p.ws + OFF_PSMID), m0);
  { const u16* Ap; const u16* Wt; ffn1_ptrs(p, l, tile, Ap, Wt); gemm_run<16>(pf, Ap, 1024, Wt, acc, smem); }
  if (next >= 0) { const u16* An; const u16* Wn; ffn1_ptrs(p, l, next, An, Wn); gemm_issue(pf, An, 1024, Wn, 1024); }
  rowss_finish(rss, rinv_s);
  acc_to_cs(acc, Cs);
  const int row = tid >> 1, half = tid & 1; const float rinv = rinv_s[row]; float v[8];
  u16* dst = (u16*)(p.ws + OFF_H) + (size_t)(m0 + row) * 4096 + n0 + half * 64;
#pragma unroll
  for (int c8 = 0; c8 < 8; ++c8) { cs_ld8(Cs, row, half * 64 + c8 * 8, v);
#pragma unroll
    for (int j = 0; j < 8; ++j) { const float r = fmaxf(v[j] * rinv, 0.f); v[j] = r * r; }
    st8(dst + c8 * 8, v); }
}

DI void tile_ffn2(const Params& p, int l, const Chunk& ck, int tile, char* smem) {
  float* Cs = (float*)smem;
  const int tid = TID(); const int mi = tile & (MTN - 1), ni = tile >> MTS; const int m0 = mi * 128, n0 = ni * 128;
  f32x16 acc[2][2]; zero_acc(acc);
  gemm_main_bf<false, 64>((const u16*)(p.ws + OFF_H) + (size_t)m0 * 4096, 4096, (const u16*)(p.ws + OFF_WFF2 + l * SZ_WFF2) + (size_t)n0 * 4096, acc, smem, nullptr);
  acc_to_cs(acc, Cs);
  const int row = tid >> 1, half = tid & 1; float ssq = 0.f;
  float* xd = p.out + (size_t)(ck.tok0 + m0 + row) * 1024 + n0 + half * 64;
  u16* xb = (u16*)(p.ws + OFF_XB) + (size_t)(m0 + row) * 1024 + n0 + half * 64;
#pragma unroll
  for (int c8 = 0; c8 < 8; ++c8) {
    float v[8], x[8]; cs_ld8(Cs, row, half * 64 + c8 * 8, v); unpack8(*(const u32x4*)(xb + c8 * 8), x);
#pragma unroll
    for (int j = 0; j < 8; ++j) { v[j] += x[j]; ssq += v[j] * v[j]; }
    if (l == 0) *(u32x4*)(xb + c8 * 8) = pack8(v);
    else { *(f32x4*)(xd + c8 * 8) = f32x4{v[0], v[1], v[2], v[3]}; *(f32x4*)(xd + c8 * 8 + 4) = f32x4{v[4], v[5], v[6], v[7]}; }
  }
  if (l == 0) ((float*)(p.ws + OFF_PSIN))[(size_t)(m0 + row) * 16 + ni * 2 + half] = ssq;
}


DI void phase_convert(const Params& p, const Chunk& ck) {
  const float* xsrc = chunk_xsrc(p, 0, ck);
  u16* xb = (u16*)(p.ws + OFF_XB); float* ps = (float*)(p.ws + OFF_PSIN);
  const int tid = TID(), lane = tid & 63, w = tid >> 6;
  const int nw = gridDim.x * 4;
  for (int row0 = BID() * 4 + w; row0 < CT; row0 += nw * 2) {
    f32x4 a[2][2], b[2][2];
#pragma unroll
    for (int u = 0; u < 2; ++u) {
      const int row = (row0 + u * nw < CT) ? row0 + u * nw : row0;
#pragma unroll
      for (int i = 0; i < 2; ++i) { const int c = (lane + 64 * i) * 8; a[u][i] = *(const f32x4*)(xsrc + (size_t)row * 1024 + c); b[u][i] = *(const f32x4*)(xsrc + (size_t)row * 1024 + c + 4); }
    }
#pragma unroll
    for (int u = 0; u < 2; ++u) {
      const int row = row0 + u * nw; if (row >= CT) break;
      float ss = 0.f;
#pragma unroll
      for (int i = 0; i < 2; ++i) {
        const int c = (lane + 64 * i) * 8; const f32x4 x = a[u][i], y = b[u][i];
        ss += x[0] * x[0] + x[1] * x[1] + x[2] * x[2] + x[3] * x[3] + y[0] * y[0] + y[1] * y[1] + y[2] * y[2] + y[3] * y[3];
        *(u32x4*)(xb + (size_t)row * 1024 + c) = u32x4{pk2(x[0], x[1]), pk2(x[2], x[3]), pk2(y[0], y[1]), pk2(y[2], y[3])};
      }
#pragma unroll
      for (int o = 32; o >= 1; o >>= 1) ss += __shfl_xor(ss, o);
      if (lane < 16) ps[(size_t)row * 16 + lane] = (lane == 0) ? ss : 0.f;
    }
  }
}

#define XB_TMO      128
#define XB_XCNT(j)  (256  + 64 * (j))
#define XB_XSUB(j)  (1280 + 64 * (j))
#define XB_XGEN(j)  (2304 + 64 * (j))
#define XB_TOP      3328
#define XB_TOPGEN   3392
#define XCD_BAR_WORDS 3456
#define XB_SPIN_CAP (1u << 22)
#define LAS __attribute__((address_space(3)))
DI unsigned xb_ld(unsigned* p)              { return __hip_atomic_load(p, __ATOMIC_RELAXED, __HIP_MEMORY_SCOPE_AGENT); }
DI unsigned xb_add(unsigned* p, unsigned v) { return __hip_atomic_fetch_add(p, v, __ATOMIC_RELAXED, __HIP_MEMORY_SCOPE_AGENT); }
DI unsigned xb_xcc_id() { return (unsigned)__builtin_amdgcn_s_getreg((3 << 11) | 20) & 0xFu; }
#define XB_SPIN(cond, bar) do { unsigned _sp = 0; while (cond) { __builtin_amdgcn_s_sleep(1); \
    if ((++_sp & 255u) == 0u) { if (xb_ld(&(bar)[XB_TMO])) break; if (_sp > XB_SPIN_CAP) { atomicAdd(&(bar)[XB_TMO], 1u); break; } } } } while (0)
struct XcdBarrier { unsigned* bar; unsigned x; volatile LAS unsigned* st; };
DI XcdBarrier xcd_barrier_post(unsigned* bar, volatile LAS unsigned* st) {
  XcdBarrier b; b.bar = bar; b.x = xb_xcc_id(); b.st = st;
  if (threadIdx.x == 0) (void)xb_add(&bar[XB_XCNT(b.x)], 1u);
  return b;
}
DI void xcd_barrier_complete(unsigned* bar, unsigned x, unsigned& nloc, unsigned& nx) {
  const unsigned G = gridDim.x * gridDim.y * gridDim.z;
  unsigned sum, cnt, mine, sp = 0u;
  for (;;) {
    sum = 0u; cnt = 0u; mine = 0u;
#pragma unroll
    for (unsigned j = 0; j < 16; ++j) { const unsigned c = xb_ld(&bar[XB_XCNT(j)]); sum += c; cnt += (c > 0u) ? 1u : 0u; mine = (j == x) ? c : mine; }
    if (sum == G) break;
    __builtin_amdgcn_s_sleep(1);
    if ((++sp & 255u) == 0u) { if (xb_ld(&bar[XB_TMO])) break; if (sp > XB_SPIN_CAP) { atomicAdd(&bar[XB_TMO], 1u); break; } }
  }
  nloc = mine > 0u ? mine : 1u; nx = cnt > 0u ? cnt : 1u;
}
DI void xcd_barrier(const XcdBarrier& b) {
  asm volatile("s_waitcnt vmcnt(0)" ::: "memory");
  __syncthreads();
  if (threadIdx.x == 0) {
    unsigned* bar = b.bar;
    __builtin_amdgcn_s_waitcnt(0);
    unsigned nloc = b.st[0], nx = b.st[1];
    if (nloc == 0u) { xcd_barrier_complete(bar, b.x, nloc, nx); b.st[0] = nloc; b.st[1] = nx; }
    const unsigned old = xb_add(&bar[XB_XSUB(b.x)], 1u);
    const unsigned gen = old / nloc;
    if (old + 1u == (gen + 1u) * nloc) {
      __builtin_amdgcn_fence(__ATOMIC_RELEASE, "agent");
      asm volatile("s_waitcnt vmcnt(0)" ::: "memory");
      const unsigned og = xb_add(&bar[XB_TOP], 1u);
      const unsigned tg = og / nx;
      if (og + 1u == (tg + 1u) * nx) xb_add(&bar[XB_TOPGEN], 1u);
      else XB_SPIN(xb_ld(&bar[XB_TOPGEN]) == tg, bar);
      __builtin_amdgcn_fence(__ATOMIC_ACQUIRE, "agent");
      xb_add(&bar[XB_XGEN(b.x)], 1u);
      asm volatile("s_waitcnt vmcnt(0)" ::: "memory");
    } else {
      XB_SPIN(xb_ld(&bar[XB_XGEN(b.x)]) == gen, bar);
      __builtin_amdgcn_fence(__ATOMIC_ACQUIRE, "agent");
      asm volatile("s_waitcnt vmcnt(0)" ::: "memory");
    }
  }
  __syncthreads();
}

enum { PH_PREP = 0, PH_MEMKV, PH_INPROJ, PH_MLAUP, PH_ATTN, PH_MERGE, PH_BRANCH, PH_OUTPROJ, PH_FFN1, PH_FFN2, PH_CONVERT };
DI void run_phase(const Params& p, int ph, int l, int c, char* smem) {
  const Chunk ck = make_chunk(c);
  switch (ph) {
    case PH_MEMKV: for (int t = BID(); t < 48 * 8; t += gridDim.x) tile_memkv(p, l, t, smem); break;
    case PH_INPROJ: {
      PF pf; int t = BID();
      if (t < MTN * 46) { const u16* A0; const u16* W0; inproj_ptrs(p, l, t, A0, W0); gemm_issue(pf, A0, 1024, W0, 1024); }
      for (; t < MTN * 46; t += gridDim.x) { const int tn = t + (int)gridDim.x; tile_inproj(p, l, ck, t, tn < MTN * 46 ? tn : -1, pf, smem); }
    } break;
    case PH_MLAUP: for (int t = BID(); t < MTN * 16; t += gridDim.x) tile_mla_up(p, l, ck, t, smem); break;
    case PH_ATTN: for (int t = BID(); t < 24 * MTN; t += gridDim.x) item_attn(p, l, ck, t, smem); break;
    case PH_MERGE: phase_merge(p); break;
    case PH_BRANCH: for (int t = BID(); t < MTN * 8; t += gridDim.x) tile_branch(p, l, t, smem); break;
    case PH_OUTPROJ: {
      PF pf; int t = BID();
      if (t < MTN * 8) { const u16* A0; const u16* W0; outproj_ptrs(p, l, t, A0, W0); gemm_issue(pf, A0, 1024, W0, 1024); }
      for (; t < MTN * 8; t += gridDim.x) { const int tn = t + (int)gridDim.x; tile_outproj(p, l, ck, t, tn < MTN * 8 ? tn : -1, pf, smem); }
    } break;
    case PH_FFN1: {
      PF pf; int t = BID();
      if (t < MTN * 32) { const u16* A0; const u16* W0; ffn1_ptrs(p, l, t, A0, W0); gemm_issue(pf, A0, 1024, W0, 1024); }
      for (; t < MTN * 32; t += gridDim.x) { const int tn = t + (int)gridDim.x; tile_ffn1(p, l, ck, t, tn < MTN * 32 ? tn : -1, pf, smem); }
    } break;
    case PH_CONVERT: phase_convert(p, ck); break;
    default: for (int t = BID(); t < MTN * 8; t += gridDim.x) tile_ffn2(p, l, ck, t, smem); break;
  }
}

__global__ void __launch_bounds__(256, 2) phase_kernel(Params p, int ph, int l, int c) {
  __shared__ __attribute__((aligned(16))) char smem[SMEM_BYTES];
  if (ph == PH_PREP) phase_prep(p, smem); else run_phase(p, ph, l, c, smem);
}

__global__ void __launch_bounds__(256, 2) mega_kernel(Params p) {
  __shared__ __attribute__((aligned(16))) char smem[SMEM_BYTES];
  __shared__ uint4 xb_words;
  cg::grid_group grid = cg::this_grid();
  if (threadIdx.x == 0) xb_words = make_uint4(0u, 0u, 0u, 0u);
  __syncthreads();
  const XcdBarrier xb = xcd_barrier_post((unsigned*)(p.ws + OFF_BAR), (volatile LAS unsigned*)&xb_words);
  phase_prep(p, smem);
  grid.sync();
#pragma unroll 1
  for (int step = 0; step < 2 + NCHUNK * 17; ++step) {
    int ph, l, c = 0;
    if (step < 2) { ph = PH_MEMKV; l = step; }
    else { const int s = step - 2; c = s / 17; const int r = s - c * 17; if (r == 0) { ph = PH_CONVERT; l = 0; } else { l = (r - 1) >> 3; ph = PH_INPROJ + ((r - 1) & 7); } }
    GAS const float* xp = (GAS const float*)p.x_prompt; GAS const float* xs = (GAS const float*)p.x_sample; GAS const float* mp = (GAS const float*)p.mem_prompt;
    GAS const float* ms = (GAS const float*)p.mem_sample; GAS float* po = (GAS float*)p.out; GAS char* pw = (GAS char*)p.ws;
    asm volatile("" : "+s"(xp), "+s"(xs), "+s"(mp), "+s"(ms), "+s"(po), "+s"(pw));
    Params q{};
    q.x_prompt = (const float*)xp; q.x_sample = (const float*)xs; q.mem_prompt = (const float*)mp; q.mem_sample = (const float*)ms; q.out = (float*)po; q.ws = (char*)pw;
    run_phase(q, ph, l, c, smem);
    xcd_barrier(xb);
  }
}

extern "C" void kernel_launch(void* const* d_in, const int* in_sizes, int n_in, void* d_out, int out_size, void* d_ws, size_t ws_size, hipStream_t stream) {
  if (n_in != 23 || ws_size < WS_END || out_size != 65536 * 1024) {
    fprintf(stderr, "kernel_launch: unexpected shapes: n_in %d out %d ws %zu (need %zu)\n", n_in, out_size, ws_size, (size_t)WS_END);
    return;
  }
  Params p{};
  const float** pf = (const float**)&p;
  for (int i = 0; i < 23; ++i) pf[i] = (const float*)d_in[i];
  p.out = (float*)d_out; p.ws = (char*)d_ws;
  static int grid = 0;
  if (grid == 0) {
    int dev = 0, cus = 0, per_cu = 0;
    hipGetDevice(&dev);
    hipDeviceGetAttribute(&cus, hipDeviceAttributeMultiprocessorCount, dev);
#if MULTI_LAUNCH
    hipOccupancyMaxActiveBlocksPerMultiprocessor(&per_cu, phase_kernel, 256, 0);
#else
    hipOccupancyMaxActiveBlocksPerMultiprocessor(&per_cu, mega_kernel, 256, 0);
#endif
    if (per_cu < 1) per_cu = 1;
    if (per_cu > 2) per_cu = 2;
    grid = cus * per_cu;
  }
#if MULTI_LAUNCH
  hipLaunchKernelGGL(phase_kernel, dim3(grid), dim3(256), 0, stream, p, (int)PH_PREP, 0, 0);
  for (int l = 0; l < 2; ++l) hipLaunchKernelGGL(phase_kernel, dim3(grid), dim3(256), 0, stream, p, (int)PH_MEMKV, l, 0);
  for (int c = 0; c < NCHUNK; ++c) {
    hipLaunchKernelGGL(phase_kernel, dim3(grid), dim3(256), 0, stream, p, (int)PH_CONVERT, 0, c);
    for (int l = 0; l < 2; ++l)
      for (int ph = PH_INPROJ; ph <= PH_FFN2; ++ph) hipLaunchKernelGGL(phase_kernel, dim3(grid), dim3(256), 0, stream, p, ph, l, c);
  }
#else
  hipMemsetAsync((char*)d_ws + OFF_BAR, 0, 16384, stream);
  void* args[] = {&p};
  hipError_t e = hipLaunchCooperativeKernel((void*)mega_kernel, dim3(grid), dim3(256), args, 0, stream);
  if (e != hipSuccess) fprintf(stderr, "cooperative launch failed: %s (grid %d)\n", hipGetErrorString(e), grid);
#endif
}
```

```cpp
#include <hip/hip_runtime.h>
#include <hip/hip_cooperative_groups.h>
#include <cstdio>
#include <cstdint>
namespace cg = cooperative_groups;

#ifndef MULTI_LAUNCH
#define MULTI_LAUNCH 0
#endif

typedef unsigned short u16;
using bf16x8 = __attribute__((ext_vector_type(8))) short;
using f32x16 = __attribute__((ext_vector_type(16))) float;
using f32x4  = __attribute__((ext_vector_type(4))) float;
using u32x4  = __attribute__((ext_vector_type(4))) unsigned;
using u32x2  = __attribute__((ext_vector_type(2))) unsigned;
typedef __bf16 bf2_t __attribute__((ext_vector_type(2)));
typedef float f2_t __attribute__((ext_vector_type(2)));
#define DI __device__ __forceinline__
#define GAS __attribute__((address_space(1)))
#define MFMA(a, b, c) __builtin_amdgcn_mfma_f32_32x32x16_bf16((a), (b), (c), 0, 0, 0)

constexpr int DM = 1024, DIN = 8864, DINP = 8960, DFF = 4096;
constexpr int CT = 16384;
constexpr int NCHUNK = 4;
constexpr int MTS = 7, MTN = 128;
constexpr float EPS = 1e-6f;
constexpr float LOG2E = 1.4426950408889634f, LN2 = 0.6931471805599453f;
constexpr float QS128 = LOG2E * 0.08838834764831845f;
constexpr float QS96  = LOG2E * 0.10206207261596575f;

constexpr size_t SZ_WIN = (size_t)DINP * 1024 * 2, SZ_WQB = 1024ull * 384 * 2, SZ_WKVB = 1024ull * 256 * 2, SZ_WMEM = 1024ull * 1024 * 2;
constexpr size_t SZ_WBR = 1024ull * 512 * 2, SZ_WOUT = 1024ull * 1024 * 2, SZ_WFF1 = 4096ull * 1024 * 2, SZ_WFF2 = 1024ull * 4096 * 2;
constexpr size_t SZ_KMEM = 6144ull * 512 * 2;
constexpr size_t OFF_WIN = 0;
constexpr size_t OFF_WQB = OFF_WIN + 2 * SZ_WIN;
constexpr size_t OFF_WKVB = OFF_WQB + 2 * SZ_WQB;
constexpr size_t OFF_WMEM = OFF_WKVB + 2 * SZ_WKVB;
constexpr size_t OFF_WBR = OFF_WMEM + 2 * SZ_WMEM;
constexpr size_t OFF_WOUT = OFF_WBR + 6 * SZ_WBR;
constexpr size_t OFF_WFF1 = OFF_WOUT + 2 * SZ_WOUT;
constexpr size_t OFF_WFF2 = OFF_WFF1 + 2 * SZ_WFF1;
constexpr size_t OFF_KMEM = OFF_WFF2 + 2 * SZ_WFF2;
constexpr size_t OFF_VMEMT = OFF_KMEM + 2 * SZ_KMEM;
constexpr size_t OFF_QD = OFF_VMEMT + 2 * SZ_KMEM;
constexpr size_t SZ_D3 = 3ull * CT * 512 * 2;
constexpr size_t OFF_KD = OFF_QD + SZ_D3;
constexpr size_t OFF_VDT = OFF_KD + SZ_D3;
constexpr size_t OFF_CQ = OFF_VDT + SZ_D3;
constexpr size_t OFF_CKV = OFF_CQ + (size_t)CT * 384 * 2;
constexpr size_t OFF_KR = OFF_CKV + (size_t)CT * 256 * 2;
constexpr size_t OFF_MQ = OFF_KR + (size_t)CT * 32 * 2;
constexpr size_t OFF_QM = OFF_MQ + (size_t)CT * 512 * 2;
constexpr size_t OFF_KM = OFF_QM + (size_t)CT * 768 * 2;
constexpr size_t OFF_VMT = OFF_KM + (size_t)CT * 768 * 2;
constexpr size_t OFF_AO = OFF_VMT + (size_t)CT * 512 * 2;
constexpr size_t OFF_LSE = OFF_AO + SZ_D3;
constexpr size_t OFF_BR = OFF_LSE + 3ull * CT * 4 * 4;
constexpr size_t OFF_U = OFF_QM;
constexpr size_t OFF_H = OFF_QD;
static_assert((size_t)CT * 1024 * 2 <= 2 * (size_t)CT * 768 * 2 && (size_t)CT * 4096 * 2 <= 3 * SZ_D3, "overlay sizes");
constexpr size_t OFF_BAR = OFF_BR + 3ull * CT * 512 * 2;
constexpr size_t OFF_GAINS = OFF_BAR + 16384;
constexpr int GN_DQ = 0, GN_DK = 3072, GN_MQ = 6144, GN_MK = 6336, GN_MEMQ = 6528, GN_MEMK = 6784, GN_TOTAL = 7040;
constexpr size_t OFF_XB = OFF_GAINS + 32768;
constexpr size_t OFF_PSIN = OFF_XB + (size_t)CT * 1024 * 2;
constexpr size_t OFF_PSMID = OFF_PSIN + (size_t)CT * 16 * 4;
constexpr size_t WS_END = OFF_PSMID + (size_t)CT * 16 * 4;

struct Params {
  const float* x_prompt; const float* x_sample; const float* mem_prompt; const float* mem_sample;
  const float* mix_norm; const float* w_in; const float* dil_q_norm; const float* dil_k_norm;
  const float* mla_q_a_norm; const float* mla_kv_a_norm; const float* w_mla_q_b; const float* w_mla_kv_b;
  const float* mla_q_norm; const float* mla_k_norm; const float* mem_norm; const float* w_mem_kv;
  const float* mem_q_norm; const float* mem_k_norm; const float* w_branch; const float* w_out;
  const float* ffn_norm; const float* w_ff1; const float* w_ff2;
  float* out; char* ws;
};

struct Chunk { int S; int sshift; int nb; int tok0; int mb0; };
DI Chunk make_chunk(int c) {
  Chunk k;
  if (c < 2) { k.S = 4096; k.sshift = 12; k.nb = 4; k.tok0 = c * CT; k.mb0 = c * 4; }
  else { k.S = 2048; k.sshift = 11; k.nb = 8; k.tok0 = 32768 + (c - 2) * CT; k.mb0 = 8 + (c - 2) * 8; }
  return k;
}

DI const float* chunk_xsrc(const Params& p, int l, const Chunk& ck) {
  GAS const float* x0 = (GAS const float*)((ck.tok0 < 32768) ? p.x_prompt + (size_t)ck.tok0 * 1024 : p.x_sample + (size_t)(ck.tok0 - 32768) * 1024);
  asm volatile("" : "+v"(x0));
  const float* x1 = p.out + (size_t)ck.tok0 * 1024;
  return (l == 0) ? (const float*)x0 : x1;
}

DI int TID() { int t = (int)__builtin_amdgcn_workitem_id_x(); asm volatile("" : "+v"(t)); return t; }
DI int BID() { int b = (int)__builtin_amdgcn_workgroup_id_x(); asm volatile("" : "+s"(b)); return b; }
DI unsigned pk2(float a, float b) { f2_t v = {a, b}; bf2_t r = __builtin_convertvector(v, bf2_t); return __builtin_bit_cast(unsigned, r); }
DI u32x4 pack8(const float (&v)[8]) { u32x4 r = {pk2(v[0], v[1]), pk2(v[2], v[3]), pk2(v[4], v[5]), pk2(v[6], v[7])}; return r; }
DI void unpack8(u32x4 u, float (&f)[8]) {
#pragma unroll
  for (int i = 0; i < 4; ++i) { f[2 * i] = __uint_as_float(u[i] << 16); f[2 * i + 1] = __uint_as_float(u[i] & 0xffff0000u); }
}
DI int crow(int r, int hi) { return (r & 3) + 8 * (r >> 2) + 4 * hi; }
DI float bf2f(u16 v) { return __uint_as_float(((unsigned)v) << 16); }

constexpr int LDT = 72;
constexpr int CSL = 132;
constexpr int GBUF = 2 * 128 * LDT;
constexpr int SMEM_CS = 2 * GBUF * 2;
constexpr int SMEM_BYTES = SMEM_CS + 512;

DI void cs_ld8(const float* Cs, int row, int col, float (&v)[8]) {
  const f32x4 a = *(const f32x4*)&Cs[row * CSL + col]; const f32x4 b = *(const f32x4*)&Cs[row * CSL + col + 4];
  v[0] = a[0]; v[1] = a[1]; v[2] = a[2]; v[3] = a[3]; v[4] = b[0]; v[5] = b[1]; v[6] = b[2]; v[7] = b[3];
}
DI void st8(u16* dst, const float (&v)[8]) { *(u32x4*)dst = pack8(v); }

template <bool AF32, bool ROWNORM, int KSU = 4>
DI void gemm_main(const void* __restrict__ Ap, int lda, const u16* __restrict__ Wt, int K, f32x16 (&acc)[2][2], char* smem, float* rinv_s) {
  const int tid = TID(), lane = tid & 63, w = tid >> 6, wm = w >> 1, wn = w & 1, r32 = lane & 31, hi = lane >> 5;
  u16* As = (u16*)smem; u16* Bs = As + 128 * LDT;
  const int srow = tid >> 3, sc8 = (tid & 7) * 8;
  float ss[4] = {0.f, 0.f, 0.f, 0.f};
  f32x4 af[8]; u32x4 ab[4]; u32x4 bb[4];
  const int nk = K >> 6;
#define GLOAD(kt) do { _Pragma("unroll") for (int i = 0; i < 4; ++i) { \
    if constexpr (AF32) { const float* a_ = (const float*)Ap + (size_t)(srow + 32 * i) * lda + (kt) * 64 + sc8; af[2 * i] = *(const f32x4*)a_; af[2 * i + 1] = *(const f32x4*)(a_ + 4); } \
    else { const u16* a_ = (const u16*)Ap + (size_t)(srow + 32 * i) * lda + (kt) * 64 + sc8; ab[i] = *(const u32x4*)a_; } \
    bb[i] = *(const u32x4*)(Wt + (size_t)(srow + 32 * i) * K + (kt) * 64 + sc8); } } while (0)
#define GSTORE(buf) do { _Pragma("unroll") for (int i = 0; i < 4; ++i) { \
    u32x4 av; \
    if constexpr (AF32) { const f32x4 lo = af[2 * i], h4 = af[2 * i + 1]; \
      av = u32x4{pk2(lo[0], lo[1]), pk2(lo[2], lo[3]), pk2(h4[0], h4[1]), pk2(h4[2], h4[3])}; \
      if constexpr (ROWNORM) ss[i] += lo[0] * lo[0] + lo[1] * lo[1] + lo[2] * lo[2] + lo[3] * lo[3] + h4[0] * h4[0] + h4[1] * h4[1] + h4[2] * h4[2] + h4[3] * h4[3]; \
    } else { av = ab[i]; \
      if constexpr (ROWNORM) { float f[8]; unpack8(av, f); _Pragma("unroll") for (int j = 0; j < 8; ++j) ss[i] += f[j] * f[j]; } } \
    *(u32x4*)&As[(buf) * GBUF + (srow + 32 * i) * LDT + sc8] = av; \
    *(u32x4*)&Bs[(buf) * GBUF + (srow + 32 * i) * LDT + sc8] = bb[i]; } } while (0)
  GLOAD(0);
  __syncthreads();
  GSTORE(0);
  __syncthreads();
  for (int kt = 0; kt < nk; ++kt) {
    const int cur = (kt & 1) * GBUF;
    if (kt + 1 < nk) GLOAD(kt + 1);
#pragma unroll KSU
    for (int ks = 0; ks < 4; ++ks) {
      const bf16x8 a0 = *(const bf16x8*)&As[cur + (wm * 64 + r32) * LDT + ks * 16 + hi * 8];
      const bf16x8 a1 = *(const bf16x8*)&As[cur + (wm * 64 + 32 + r32) * LDT + ks * 16 + hi * 8];
      const bf16x8 b0 = *(const bf16x8*)&Bs[cur + (wn * 64 + r32) * LDT + ks * 16 + hi * 8];
      const bf16x8 b1 = *(const bf16x8*)&Bs[cur + (wn * 64 + 32 + r32) * LDT + ks * 16 + hi * 8];
      acc[0][0] = MFMA(a0, b0, acc[0][0]); acc[0][1] = MFMA(a0, b1, acc[0][1]);
      acc[1][0] = MFMA(a1, b0, acc[1][0]); acc[1][1] = MFMA(a1, b1, acc[1][1]);
    }
    if (kt + 1 < nk) { const int nb_ = ((kt + 1) & 1); GSTORE(nb_); }
    __syncthreads();
  }
#undef GSTORE
#undef GLOAD
  if constexpr (ROWNORM) {
#pragma unroll
    for (int i = 0; i < 4; ++i) {
      float s = ss[i]; s += __shfl_xor(s, 1); s += __shfl_xor(s, 2); s += __shfl_xor(s, 4);
      if ((tid & 7) == 0) rinv_s[srow + 32 * i] = rsqrtf(s / (float)K + EPS);
    }
  }
}

template <bool ROWNORM, int NK>
DI void gemm_main_bf(const u16* __restrict__ Ap, int lda, const u16* __restrict__ Wt, f32x16 (&acc)[2][2], char* smem, float* rinv_s) {
  constexpr int K = NK * 64;
  const int tid = TID(), lane = tid & 63, w = tid >> 6, wm = w >> 1, wn = w & 1, r32 = lane & 31, hi = lane >> 5;
  u16* As = (u16*)smem; u16* Bs = As + 128 * LDT;
  const int srow = tid >> 3, sc8 = (tid & 7) * 8;
  float ss[4] = {0.f, 0.f, 0.f, 0.f};
  u32x4 a0[4], b0[4], a1[4], b1[4];
  constexpr int nk = NK;
  const unsigned aoff = (unsigned)(srow * lda + sc8) * 2u, woff = (unsigned)(srow * K + sc8) * 2u;
#define BLOAD(A_, B_, kt) do { _Pragma("unroll") for (int i = 0; i < 4; ++i) { \
    A_[i] = *(const u32x4*)((const char*)Ap + (aoff + (unsigned)(32 * i * lda + (kt) * 64) * 2u)); B_[i] = *(const u32x4*)((const char*)Wt + (woff + (unsigned)(32 * i * K + (kt) * 64) * 2u)); } } while (0)
#define BSTORE(A_, B_, buf) do { _Pragma("unroll") for (int i = 0; i < 4; ++i) { \
    if constexpr (ROWNORM) { float f[8]; unpack8(A_[i], f); _Pragma("unroll") for (int j = 0; j < 8; ++j) ss[i] += f[j] * f[j]; asm volatile("" : "+v"(ss[i])); } \
    *(u32x4*)&As[(buf) * GBUF + (srow + 32 * i) * LDT + sc8] = A_[i]; \
    *(u32x4*)&Bs[(buf) * GBUF + (srow + 32 * i) * LDT + sc8] = B_[i]; } } while (0)
#define BCOMP(buf) do { __builtin_amdgcn_s_setprio(1); _Pragma("unroll") for (int ks = 0; ks < 4; ++ks) { \
      const bf16x8 fa0 = *(const bf16x8*)&As[(buf) * GBUF + (wm * 64 + r32) * LDT + ks * 16 + hi * 8]; \
      const bf16x8 fa1 = *(const bf16x8*)&As[(buf) * GBUF + (wm * 64 + 32 + r32) * LDT + ks * 16 + hi * 8]; \
      const bf16x8 fb0 = *(const bf16x8*)&Bs[(buf) * GBUF + (wn * 64 + r32) * LDT + ks * 16 + hi * 8]; \
      const bf16x8 fb1 = *(const bf16x8*)&Bs[(buf) * GBUF + (wn * 64 + 32 + r32) * LDT + ks * 16 + hi * 8]; \
      acc[0][0] = MFMA(fa0, fb0, acc[0][0]); acc[0][1] = MFMA(fa0, fb1, acc[0][1]); \
      acc[1][0] = MFMA(fa1, fb0, acc[1][0]); acc[1][1] = MFMA(fa1, fb1, acc[1][1]); } __builtin_amdgcn_s_setprio(0); } while (0)
  __builtin_amdgcn_s_setprio(0);
  BLOAD(a0, b0, 0); BLOAD(a1, b1, 1);
  __syncthreads();
  BSTORE(a0, b0, 0);
  BLOAD(a0, b0, 2);
  __syncthreads();
#pragma unroll
  for (int kt = 0; kt < nk; kt += 2) {
    BCOMP(0);
    BSTORE(a1, b1, 1);
    if (kt + 3 < nk) BLOAD(a1, b1, kt + 3);
    __syncthreads();
    BCOMP(1);
    if (kt + 2 < nk) { BSTORE(a0, b0, 0); if (kt + 4 < nk) BLOAD(a0, b0, kt + 4); }
    __syncthreads();
  }
#undef BLOAD
#undef BSTORE
#undef BCOMP
  if constexpr (ROWNORM) {
#pragma unroll
    for (int i = 0; i < 4; ++i) {
      float s = ss[i]; s += __shfl_xor(s, 1); s += __shfl_xor(s, 2); s += __shfl_xor(s, 4);
      if ((tid & 7) == 0) rinv_s[srow + 32 * i] = rsqrtf(s / (float)K + EPS);
    }
  }
}

struct RowSS { f32x4 a, b; };
DI RowSS rowss_load(const float* ps, int m0) { const int tid = TID(); const float* q = ps + (size_t)(m0 + (tid >> 1)) * 16 + (tid & 1) * 8; RowSS r; r.a = *(const f32x4*)q; r.b = *(const f32x4*)(q + 4); return r; }
DI void rowss_finish(const RowSS& r, float* rinv_s) {
  const int tid = TID();
  float s = (r.a[0] + r.a[1]) + (r.a[2] + r.a[3]) + (r.b[0] + r.b[1]) + (r.b[2] + r.b[3]);
  s += __shfl_xor(s, 1);
  if ((tid & 1) == 0) rinv_s[tid >> 1] = rsqrtf(s * (1.f / 1024.f) + EPS);
}

struct PF { u32x4 a0[4], b0[4], a1[4], b1[4]; };
DI void gemm_issue(PF& pf, const u16* __restrict__ Ap, int lda, const u16* __restrict__ Wt, int K) {
  const int tid = TID(); const int srow = tid >> 3, sc8 = (tid & 7) * 8;
  const unsigned aoff = (unsigned)(srow * lda + sc8) * 2u, woff = (unsigned)(srow * K + sc8) * 2u;
#pragma unroll
  for (int i = 0; i < 4; ++i) {
    pf.a0[i] = *(const u32x4*)((const char*)Ap + (aoff + (unsigned)(32 * i * lda) * 2u)); pf.b0[i] = *(const u32x4*)((const char*)Wt + (woff + (unsigned)(32 * i * K) * 2u));
  }
#pragma unroll
  for (int i = 0; i < 4; ++i) {
    pf.a1[i] = *(const u32x4*)((const char*)Ap + (aoff + (unsigned)(32 * i * lda + 64) * 2u)); pf.b1[i] = *(const u32x4*)((const char*)Wt + (woff + (unsigned)(32 * i * K + 64) * 2u));
  }
}
template <int NK>
DI void gemm_run(PF& pf, const u16* __restrict__ Ap, int lda, const u16* __restrict__ Wt, f32x16 (&acc)[2][2], char* smem) {
  constexpr int K = NK * 64;
  const int tid = TID(), lane = tid & 63, w = tid >> 6, wm = w >> 1, wn = w & 1, r32 = lane & 31, hi = lane >> 5;
  u16* As = (u16*)smem; u16* Bs = As + 128 * LDT;
  const int srow = tid >> 3, sc8 = (tid & 7) * 8;
  constexpr int nk = NK;
  const unsigned aoff = (unsigned)(srow * lda + sc8) * 2u, woff = (unsigned)(srow * K + sc8) * 2u;
#define BLOAD(A_, B_, kt) do { _Pragma("unroll") for (int i = 0; i < 4; ++i) { \
    A_[i] = *(const u32x4*)((const char*)Ap + (aoff + (unsigned)(32 * i * lda + (kt) * 64) * 2u)); B_[i] = *(const u32x4*)((const char*)Wt + (woff + (unsigned)(32 * i * K + (kt) * 64) * 2u)); } } while (0)
#define BSTORE(A_, B_, buf) do { _Pragma("unroll") for (int i = 0; i < 4; ++i) { \
    *(u32x4*)&As[(buf) * GBUF + (srow + 32 * i) * LDT + sc8] = A_[i]; \
    *(u32x4*)&Bs[(buf) * GBUF + (srow + 32 * i) * LDT + sc8] = B_[i]; } } while (0)
#define BCOMP(buf) do { __builtin_amdgcn_s_setprio(1); _Pragma("unroll") for (int ks = 0; ks < 4; ++ks) { \
      const bf16x8 fa0 = *(const bf16x8*)&As[(buf) * GBUF + (wm * 64 + r32) * LDT + ks * 16 + hi * 8]; \
      const bf16x8 fa1 = *(const bf16x8*)&As[(buf) * GBUF + (wm * 64 + 32 + r32) * LDT + ks * 16 + hi * 8]; \
      const bf16x8 fb0 = *(const bf16x8*)&Bs[(buf) * GBUF + (wn * 64 + r32) * LDT + ks * 16 + hi * 8]; \
      const bf16x8 fb1 = *(const bf16x8*)&Bs[(buf) * GBUF + (wn * 64 + 32 + r32) * LDT + ks * 16 + hi * 8]; \
      acc[0][0] = MFMA(fa0, fb0, acc[0][0]); acc[0][1] = MFMA(fa0, fb1, acc[0][1]); \
      acc[1][0] = MFMA(fa1, fb0, acc[1][0]); acc[1][1] = MFMA(fa1, fb1, acc[1][1]); } __builtin_amdgcn_s_setprio(0); } while (0)
  __builtin_amdgcn_s_setprio(0);
  __syncthreads();
  BSTORE(pf.a0, pf.b0, 0);
  BLOAD(pf.a0, pf.b0, 2);
  __syncthreads();
#pragma unroll
  for (int kt = 0; kt < nk; kt += 2) {
    BCOMP(0);
    BSTORE(pf.a1, pf.b1, 1);
    if (kt + 3 < nk) BLOAD(pf.a1, pf.b1, kt + 3);
    __syncthreads();
    BCOMP(1);
    if (kt + 2 < nk) { BSTORE(pf.a0, pf.b0, 0); if (kt + 4 < nk) BLOAD(pf.a0, pf.b0, kt + 4); }
    __syncthreads();
  }
#undef BLOAD
#undef BSTORE
#undef BCOMP
}

DI void zero_acc(f32x16 (&acc)[2][2]) {
#pragma unroll
  for (int a = 0; a < 2; ++a)
#pragma unroll
    for (int b = 0; b < 2; ++b)
#pragma unroll
      for (int r = 0; r < 16; ++r) acc[a][b][r] = 0.f;
}

DI void acc_to_cs(const f32x16 (&acc)[2][2], float* Cs) {
  __builtin_amdgcn_s_setprio(2);
  const int tid = TID(), lane = tid & 63, w = tid >> 6, wm = w >> 1, wn = w & 1, r32 = lane & 31, hi = lane >> 5;
#pragma unroll
  for (int mt = 0; mt < 2; ++mt)
#pragma unroll
    for (int nt = 0; nt < 2; ++nt)
#pragma unroll
      for (int r = 0; r < 16; ++r) Cs[(wm * 64 + mt * 32 + crow(r, hi)) * CSL + wn * 64 + nt * 32 + r32] = acc[mt][nt][r];
  __syncthreads();
}

DI void rope32(float (&x)[32], int pos) {
#pragma unroll
  for (int i = 0; i < 16; ++i) {
    const float inv = __builtin_amdgcn_exp2f(-(float)i * (0.0625f * 13.287712379549449f));
    const float ang = (float)pos * inv;
    float rev = ang * 0.15915494309189535f; rev = rev - floorf(rev);
    const float s = __builtin_amdgcn_sinf(rev), c = __builtin_amdgcn_cosf(rev);
    const float a = x[i], b = x[16 + i];
    x[i] = a * c - b * s; x[16 + i] = a * s + b * c;
  }
}

DI int colmap(int mode, int n) {
  if (mode == 1) return n < 5248 ? n : (n < 5280 ? 8832 + (n - 5248) : n - 32);
  if (mode == 2) return (n / 96) * 128 + (n % 96);
  return n;
}
DI void prep_tile(const float* __restrict__ W, int K, int N, const float* __restrict__ gain, u16* __restrict__ dst, int mode, int tile, char* smem) {
  float* Ts = (float*)smem;
  const int ntn = (N + 63) >> 6; const int kt = tile / ntn, nt = tile - kt * ntn; const int k0 = kt * 64, n0 = nt * 64;
  const int tid = TID(), tx = tid & 63, ty = tid >> 6;
  __syncthreads();
  {
    const int n = n0 + tx; float v[16], g[16];
#pragma unroll
    for (int kk = 0; kk < 16; ++kk) v[kk] = (n < N) ? W[(size_t)(k0 + kk * 4 + ty) * N + n] : 0.f;
#pragma unroll
    for (int kk = 0; kk < 16; ++kk) g[kk] = gain ? gain[k0 + kk * 4 + ty] : 1.f;
#pragma unroll
    for (int kk = 0; kk < 16; ++kk) Ts[tx * 65 + kk * 4 + ty] = v[kk] * g[kk];
  }
  __syncthreads();
#pragma unroll
  for (int i = 0; i < 2; ++i) {
    const int cid = tid + 256 * i, nl = cid >> 3, kc = cid & 7, n = n0 + nl;
    if (n < N) {
      float v[8];
#pragma unroll
      for (int j = 0; j < 8; ++j) v[j] = Ts[nl * 65 + kc * 8 + j];
      st8(dst + (size_t)colmap(mode, n) * K + k0 + kc * 8, v);
    }
  }
}

DI void phase_prep(const Params& p, char* smem) {
  u16* ws16 = (u16*)p.ws;
  for (int e = 0; e < 20; ++e) {
    const int l = e / 10, k = e % 10;
    const float* W; const float* gain = nullptr; u16* dst; int K, N, mode = 0;
    switch (k) {
      case 0: W = p.w_in + (size_t)l * 1024 * DIN; K = 1024; N = DIN; gain = p.mix_norm + l * 1024; dst = (u16*)(p.ws + OFF_WIN + l * SZ_WIN); mode = 1; break;
      case 1: W = p.w_mla_q_b + (size_t)l * 384 * 768; K = 384; N = 768; gain = p.mla_q_a_norm + l * 384; dst = (u16*)(p.ws + OFF_WQB + l * SZ_WQB); mode = 2; break;
      case 2: W = p.w_mla_kv_b + (size_t)l * 256 * 1024; K = 256; N = 1024; gain = p.mla_kv_a_norm + l * 256; dst = (u16*)(p.ws + OFF_WKVB + l * SZ_WKVB); break;
      case 3: W = p.w_mem_kv + (size_t)l * 1024 * 1024; K = 1024; N = 1024; gain = p.mem_norm + l * 1024; dst = (u16*)(p.ws + OFF_WMEM + l * SZ_WMEM); break;
      case 4: case 5: case 6: W = p.w_branch + (size_t)(l * 3 + (k - 4)) * 512 * 1024; K = 512; N = 1024; dst = (u16*)(p.ws + OFF_WBR + (l * 3 + (k - 4)) * SZ_WBR); break;
      case 7: W = p.w_out + (size_t)l * 1024 * 1024; K = 1024; N = 1024; dst = (u16*)(p.ws + OFF_WOUT + l * SZ_WOUT); break;
      case 8: W = p.w_ff1 + (size_t)l * 1024 * 4096; K = 1024; N = 4096; gain = p.ffn_norm + l * 1024; dst = (u16*)(p.ws + OFF_WFF1 + l * SZ_WFF1); break;
      default: W = p.w_ff2 + (size_t)l * 4096 * 1024; K = 4096; N = 1024; dst = (u16*)(p.ws + OFF_WFF2 + l * SZ_WFF2); break;
    }
    const int nt = (K >> 6) * ((N + 63) >> 6);
    for (int t = BID(); t < nt; t += gridDim.x) prep_tile(W, K, N, gain, dst, mode, t, smem);
  }
  (void)ws16;
  {
    float* gt = (float*)(p.ws + OFF_GAINS);
    for (int i = BID() * 256 + TID(); i < GN_TOTAL; i += gridDim.x * 256) {
      float v;
      if (i < GN_DK) v = p.dil_q_norm[i]; else if (i < GN_MQ) v = p.dil_k_norm[i - GN_DK]; else if (i < GN_MK) v = p.mla_q_norm[i - GN_MQ];
      else if (i < GN_MEMQ) v = p.mla_k_norm[i - GN_MK]; else if (i < GN_MEMK) v = p.mem_q_norm[i - GN_MEMQ]; else v = p.mem_k_norm[i - GN_MEMK];
      gt[i] = v;
    }
  }
  const u32x4 z = {0u, 0u, 0u, 0u};
  const int gtid = BID() * 256 + TID(), gsz = gridDim.x * 256;
  for (int l = 0; l < 2; ++l) {
    u16* d1 = (u16*)(p.ws + OFF_WIN + l * SZ_WIN) + (size_t)DIN * 1024;
    for (int i = gtid; i < 96 * 1024 / 8; i += gsz) *(u32x4*)(d1 + (size_t)i * 8) = z;
    u16* d2 = (u16*)(p.ws + OFF_WQB + l * SZ_WQB);
    for (int i = gtid; i < 8 * 32 * 384 / 8; i += gsz) {
      const int h = i / (32 * 48), rem = i - h * (32 * 48), rr = rem / 48, c8 = rem - rr * 48;
      *(u32x4*)(d2 + (size_t)(h * 128 + 96 + rr) * 384 + c8 * 8) = z;
    }
  }
}

DI void tile_memkv(const Params& p, int l, int tile, char* smem) {
  float* Cs = (float*)smem; float* rinv_s = (float*)(smem + SMEM_CS);
  const int mi = tile % 48, ni = tile / 48; const int m0 = mi * 128;
  const float* A = (m0 < 2048) ? p.mem_prompt + (size_t)m0 * 1024 : p.mem_sample + (size_t)(m0 - 2048) * 1024;
  const u16* Wt = (const u16*)(p.ws + OFF_WMEM + l * SZ_WMEM) + (size_t)ni * 128 * 1024;
  f32x16 acc[2][2]; zero_acc(acc);
  gemm_main<true, true>(A, 1024, Wt, 1024, acc, smem, rinv_s);
  acc_to_cs(acc, Cs);
  const int tid = TID();
  if (ni < 4) {
    const int row = tid >> 1, half = tid & 1; const float rinv = rinv_s[row];
    const float* gain = (const float*)(p.ws + OFF_GAINS) + GN_MEMK + l * 128;
    float ssq = 0.f; float v[8];
#pragma unroll
    for (int c8 = 0; c8 < 8; ++c8) { cs_ld8(Cs, row, half * 64 + c8 * 8, v);
#pragma unroll
      for (int j = 0; j < 8; ++j) ssq += v[j] * v[j]; }
    ssq *= rinv * rinv; ssq += __shfl_xor(ssq, 1);
    const float rn = rsqrtf(ssq * (1.f / 128.f) + EPS) * rinv;
    u16* dst = (u16*)(p.ws + OFF_KMEM + l * SZ_KMEM) + (size_t)(m0 + row) * 512 + ni * 128 + half * 64;
#pragma unroll
    for (int c8 = 0; c8 < 8; ++c8) { cs_ld8(Cs, row, half * 64 + c8 * 8, v);
#pragma unroll
      for (int j = 0; j < 8; ++j) v[j] = v[j] * rn * gain[half * 64 + c8 * 8 + j];
      st8(dst + c8 * 8, v); }
  } else {
    const int h = ni - 4, col = tid & 127, c0 = tid >> 7; const int b = m0 >> 8, pos0 = m0 & 255;
    u16* dstb = (u16*)(p.ws + OFF_VMEMT + l * SZ_KMEM) + ((size_t)(b * 4 + h) * 128 + col) * 256 + pos0;
#pragma unroll
    for (int i = 0; i < 8; ++i) {
      const int cid = c0 + 2 * i; float v[8];
#pragma unroll
      for (int j = 0; j < 8; ++j) { const int lrow = cid * 8 + j; v[j] = Cs[lrow * CSL + col] * rinv_s[lrow]; }
      st8(dstb + cid * 8, v);
    }
  }
}

DI void inproj_ptrs(const Params& p, int l, int tile, const u16*& Ap, const u16*& Wt) {
  const int mi = tile & (MTN - 1), nj = tile >> MTS; const int ni = (nj < 45) ? nj : 69;
  Ap = (const u16*)(p.ws + OFF_XB) + (size_t)(mi * 128) * 1024; Wt = (const u16*)(p.ws + OFF_WIN + l * SZ_WIN) + (size_t)ni * 128 * 1024;
}
DI void tile_inproj(const Params& p, int l, const Chunk& ck, int tile, int next, PF& pf, char* smem) {
  float* Cs = (float*)smem; float* rinv_s = (float*)(smem + SMEM_CS);
  const int mi = tile & (MTN - 1), nj = tile >> MTS; const int ni = (nj < 45) ? nj : 69; const int m0 = mi * 128;
  const u16* Ap; const u16* Wt; inproj_ptrs(p, l, tile, Ap, Wt);
  f32x16 acc[2][2]; zero_acc(acc);
  const RowSS rss = rowss_load((const float*)(p.ws + OFF_PSIN), m0);
  gemm_run<16>(pf, Ap, 1024, Wt, acc, smem);
  if (next >= 0) { const u16* An; const u16* Wn; inproj_ptrs(p, l, next, An, Wn); gemm_issue(pf, An, 1024, Wn, 1024); }
  rowss_finish(rss, rinv_s);
  acc_to_cs(acc, Cs);
  const int tid = TID(), row = tid >> 1, half = tid & 1;
  const int lt = m0 + row; const int S = ck.S; const int bl = lt >> ck.sshift, t = lt & (S - 1);
  const float rinv = rinv_s[row];
  float v[8];
  if (ni < 24 || (ni >= 41 && ni < 45)) {
    const float* gain; u16* dst; float scale;
    if (ni < 24) {
      const int g = (ni % 12) >> 2, h = ni & 3; const bool isq = ni < 12; const int dsh = 2 * g, d = 1 << dsh, Lg = S >> dsh;
      gain = (const float*)(p.ws + OFF_GAINS) + (isq ? GN_DQ : GN_DK) + ((l * 3 + g) * 4 + h) * 128;
      const int pp = (t & (d - 1)) * Lg + (t >> dsh);
      dst = (u16*)(p.ws + (isq ? OFF_QD : OFF_KD)) + ((size_t)(g * CT + bl * S + pp)) * 512 + h * 128 + half * 64;
      scale = isq ? QS128 : 1.f;
    } else {
      const int h = ni - 41; gain = (const float*)(p.ws + OFF_GAINS) + GN_MEMQ + l * 128;
      dst = (u16*)(p.ws + OFF_MQ) + (size_t)lt * 512 + h * 128 + half * 64; scale = QS128;
    }
    float ssq = 0.f;
#pragma unroll
    for (int c8 = 0; c8 < 8; ++c8) { cs_ld8(Cs, row, half * 64 + c8 * 8, v);
#pragma unroll
      for (int j = 0; j < 8; ++j) ssq += v[j] * v[j]; }
    ssq *= rinv * rinv; ssq += __shfl_xor(ssq, 1);
    const float rn = rsqrtf(ssq * (1.f / 128.f) + EPS) * rinv * scale;
#pragma unroll
    for (int c8 = 0; c8 < 8; ++c8) { cs_ld8(Cs, row, half * 64 + c8 * 8, v);
#pragma unroll
      for (int j = 0; j < 8; ++j) v[j] = v[j] * rn * gain[half * 64 + c8 * 8 + j];
      st8(dst + c8 * 8, v); }
  } else if (ni < 36) {
    const int g = (ni - 24) >> 2, h = (ni - 24) & 3; const int dsh = 2 * g, d = 1 << dsh, Lg = S >> dsh;
    const int col = tid & 127, c0 = tid >> 7; const int blk = m0 >> ck.sshift, t0 = m0 & (S - 1), ub = t0 >> dsh;
    u16* dstb = (u16*)(p.ws + OFF_VDT) + ((size_t)((g * ck.nb + blk) * 4 + h) * 128 + col) * S;
#pragma unroll
    for (int i = 0; i < 8; ++i) {
      const int cid = c0 + 2 * i, r = cid & (d - 1), uc = cid >> dsh;
#pragma unroll
      for (int j = 0; j < 8; ++j) { const int lrow = ((uc * 8 + j) << dsh) + r; v[j] = Cs[lrow * CSL + col] * rinv_s[lrow]; }
      st8(dstb + r * Lg + ub + uc * 8, v);
    }
  } else if (ni < 41) {
    u16* dst = (ni < 39) ? (u16*)(p.ws + OFF_CQ) + (size_t)lt * 384 + (ni - 36) * 128 + half * 64 : (u16*)(p.ws + OFF_CKV) + (size_t)lt * 256 + (ni - 39) * 128 + half * 64;
#pragma unroll
    for (int c8 = 0; c8 < 8; ++c8) { cs_ld8(Cs, row, half * 64 + c8 * 8, v);
#pragma unroll
      for (int j = 0; j < 8; ++j) v[j] *= rinv;
      st8(dst + c8 * 8, v); }
  } else {
    if (half == 0) {
      u16* dst = (u16*)(p.ws + OFF_KR) + (size_t)lt * 32;
#pragma unroll
      for (int c8 = 0; c8 < 4; ++c8) { cs_ld8(Cs, row, c8 * 8, v);
#pragma unroll
        for (int j = 0; j < 8; ++j) v[j] *= rinv;
        st8(dst + c8 * 8, v); }
    }
  }
}

DI void tile_mla_up(const Params& p, int l, const Chunk& ck, int tile, char* smem) {
  float* Cs = (float*)smem; float* rinv_s = (float*)(smem + SMEM_CS);
  const int mi = tile & (MTN - 1), ni = tile >> MTS; const int m0 = mi * 128;
  const int tid = TID(), row = tid >> 1, half = tid & 1;
  const int lt = m0 + row; const int S = ck.S; const int t = lt & (S - 1);
  f32x16 acc[2][2]; zero_acc(acc);
  float v[8];
  if (ni < 8) {
    const int h = ni;
    gemm_main_bf<true, 6>((const u16*)(p.ws + OFF_CQ) + (size_t)m0 * 384, 384, (const u16*)(p.ws + OFF_WQB + l * SZ_WQB) + (size_t)h * 128 * 384, acc, smem, rinv_s);
    acc_to_cs(acc, Cs);
    const float rinv = rinv_s[row]; const float* gain = (const float*)(p.ws + OFF_GAINS) + GN_MQ + l * 96;
    float ssq = 0.f;
    if (half == 0) {
#pragma unroll
      for (int c8 = 0; c8 < 8; ++c8) { cs_ld8(Cs, row, c8 * 8, v);
#pragma unroll
        for (int j = 0; j < 8; ++j) ssq += v[j] * v[j]; }
    } else {
#pragma unroll
      for (int c8 = 0; c8 < 4; ++c8) { cs_ld8(Cs, row, 64 + c8 * 8, v);
#pragma unroll
        for (int j = 0; j < 8; ++j) ssq += v[j] * v[j]; }
    }
    ssq *= rinv * rinv; ssq += __shfl_xor(ssq, 1);
    const float rn = rsqrtf(ssq * (1.f / 96.f) + EPS) * rinv * QS96;
    u16* dst = (u16*)(p.ws + OFF_QM) + (size_t)lt * 768 + h * 96;
    if (half == 0) {
#pragma unroll
      for (int c8 = 0; c8 < 8; ++c8) { cs_ld8(Cs, row, c8 * 8, v);
#pragma unroll
        for (int j = 0; j < 8; ++j) v[j] = v[j] * rn * gain[c8 * 8 + j];
        st8(dst + c8 * 8, v); }
    } else {
      float x[32];
#pragma unroll
      for (int c8 = 0; c8 < 4; ++c8) { cs_ld8(Cs, row, 64 + c8 * 8, v);
#pragma unroll
        for (int j = 0; j < 8; ++j) x[c8 * 8 + j] = v[j] * rn * gain[64 + c8 * 8 + j]; }
      rope32(x, t);
#pragma unroll
      for (int c8 = 0; c8 < 4; ++c8) {
#pragma unroll
        for (int j = 0; j < 8; ++j) v[j] = x[c8 * 8 + j];
        st8(dst + 64 + c8 * 8, v); }
    }
  } else {
    const int h = ni - 8;
    gemm_main_bf<true, 4>((const u16*)(p.ws + OFF_CKV) + (size_t)m0 * 256, 256, (const u16*)(p.ws + OFF_WKVB + l * SZ_WKVB) + (size_t)h * 128 * 256, acc, smem, rinv_s);
    acc_to_cs(acc, Cs);
    const float rinv = rinv_s[row]; const float* gain = (const float*)(p.ws + OFF_GAINS) + GN_MK + l * 96;
    float ssq = 0.f; float x[32];
    if (half == 0) {
#pragma unroll
      for (int c8 = 0; c8 < 8; ++c8) { cs_ld8(Cs, row, c8 * 8, v);
#pragma unroll
        for (int j = 0; j < 8; ++j) ssq += v[j] * v[j]; }
      ssq *= rinv * rinv;
    } else {
      const u16* kr = (const u16*)(p.ws + OFF_KR) + (size_t)lt * 32;
#pragma unroll
      for (int c8 = 0; c8 < 4; ++c8) { const u32x4 u = *(const u32x4*)(kr + c8 * 8); unpack8(u, v);
#pragma unroll
        for (int j = 0; j < 8; ++j) { x[c8 * 8 + j] = v[j]; ssq += v[j] * v[j]; } }
    }
    ssq += __shfl_xor(ssq, 1);
    const float rn = rsqrtf(ssq * (1.f / 96.f) + EPS);
    u16* dst = (u16*)(p.ws + OFF_KM) + (size_t)lt * 768 + h * 96;
    if (half == 0) {
      const float rr = rn * rinv;
#pragma unroll
      for (int c8 = 0; c8 < 8; ++c8) { cs_ld8(Cs, row, c8 * 8, v);
#pragma unroll
        for (int j = 0; j < 8; ++j) v[j] = v[j] * rr * gain[c8 * 8 + j];
        st8(dst + c8 * 8, v); }
    } else {
#pragma unroll
      for (int e = 0; e < 32; ++e) x[e] = x[e] * rn * gain[64 + e];
      rope32(x, t);
#pragma unroll
      for (int c8 = 0; c8 < 4; ++c8) {
#pragma unroll
        for (int j = 0; j < 8; ++j) v[j] = x[c8 * 8 + j];
        st8(dst + 64 + c8 * 8, v); }
    }
    const int col = tid & 63, c0 = tid >> 6; const int blk = m0 >> ck.sshift, t0 = m0 & (S - 1);
    u16* dstb = (u16*)(p.ws + OFF_VMT) + ((size_t)(blk * 8 + h) * 64 + col) * S + t0;
#pragma unroll
    for (int i = 0; i < 4; ++i) {
      const int cid = c0 + 4 * i;
#pragma unroll
      for (int j = 0; j < 8; ++j) { const int lrow = cid * 8 + j; v[j] = Cs[lrow * CSL + 64 + col] * rinv_s[lrow]; }
      st8(dstb + cid * 8, v);
    }
  }
}

DI float xhalf_max(float x) { const auto rr = __builtin_amdgcn_permlane32_swap(__float_as_uint(x), __float_as_uint(x), false, false); return fmaxf(__uint_as_float(rr[0]), __uint_as_float(rr[1])); }
DI float xhalf_sum(float x) { const auto rr = __builtin_amdgcn_permlane32_swap(__float_as_uint(x), __float_as_uint(x), false, false); return __uint_as_float(rr[0]) + __uint_as_float(rr[1]); }

template <int DQK, int DV, bool BAND>
DI void attn_block(const u16* __restrict__ Q, int ldq, const u16* __restrict__ Kp, int ldk, const u16* __restrict__ Vt, int ldv,
                   int nkeys, int q0, float bias_step, u16* __restrict__ O, int ostride, float* __restrict__ LSE, int lsestride, char* smem) {
  constexpr int KLD = DQK + 8, VLD = 68, ND0 = DQK / 16, NCB = DV / 32;
  constexpr int KCPR = DQK / 8, KCH = 64 * KCPR / 256, VCH = DV * 8 / 256;
  const int tid = TID(), lane = tid & 63, w = tid >> 6, r32 = lane & 31, hi = lane >> 5;
  u16* Ks = (u16*)smem; u16* Vs = (u16*)(smem + 17408); float* sc = (float*)(smem + 34816) + w * 64;
  const int qw0 = q0 + w * 32, qi = qw0 + r32;
  bf16x8 qf[ND0];
#pragma unroll
  for (int d0 = 0; d0 < ND0; ++d0) qf[d0] = *(const bf16x8*)(Q + (size_t)(w * 32 + r32) * ldq + d0 * 16 + hi * 8);
  f32x16 o[NCB];
#pragma unroll
  for (int cb = 0; cb < NCB; ++cb)
#pragma unroll
    for (int r = 0; r < 16; ++r) o[cb][r] = 0.f;
  float m_run = -INFINITY, l_run = 0.f;
  int kt_lo = 0, kt_hi = nkeys >> 6;
  if (BAND) { kt_lo = max(0, (q0 >> 6) - 1); kt_hi = min(nkeys >> 6, (q0 >> 6) + 3); }
  u32x4 kreg[KCH], vreg[VCH];
#define ALOAD(kt) do { \
    _Pragma("unroll") for (int i = 0; i < KCH; ++i) { const int cid = tid + 256 * i, row = cid / KCPR, c8 = cid - row * KCPR; kreg[i] = *(const u32x4*)(Kp + (size_t)((kt) * 64 + row) * ldk + c8 * 8); } \
    _Pragma("unroll") for (int i = 0; i < VCH; ++i) { const int cid = tid + 256 * i, row = cid >> 3, c8 = cid & 7; vreg[i] = *(const u32x4*)(Vt + (size_t)row * ldv + (kt) * 64 + c8 * 8); } } while (0)
  constexpr bool PREF = true;
  if (PREF) ALOAD(kt_lo);
  for (int kt = kt_lo; kt < kt_hi; ++kt) {
    __syncthreads();
    if (!PREF) ALOAD(kt);
#pragma unroll
    for (int i = 0; i < KCH; ++i) { const int cid = tid + 256 * i, row = cid / KCPR, c8 = cid - row * KCPR; *(u32x4*)&Ks[row * KLD + c8 * 8] = kreg[i]; }
#pragma unroll
    for (int i = 0; i < VCH; ++i) { const int cid = tid + 256 * i, row = cid >> 3, c8 = cid & 7;
      *(u32x2*)&Vs[row * VLD + c8 * 8] = u32x2{vreg[i][0], vreg[i][1]}; *(u32x2*)&Vs[row * VLD + c8 * 8 + 4] = u32x2{vreg[i][2], vreg[i][3]}; }
    __syncthreads();
    if (PREF && kt + 1 < kt_hi) ALOAD(kt + 1);
    if constexpr (DQK < 128) {
      f32x16 p0, p1;
#pragma unroll
      for (int r = 0; r < 16; ++r) { p0[r] = 0.f; p1[r] = 0.f; }
      __builtin_amdgcn_s_setprio(1);
#pragma unroll
      for (int d0 = 0; d0 < ND0; ++d0) {
        const bf16x8 k0f = *(const bf16x8*)&Ks[r32 * KLD + d0 * 16 + hi * 8];
        const bf16x8 k1f = *(const bf16x8*)&Ks[(32 + r32) * KLD + d0 * 16 + hi * 8];
        p0 = MFMA(k0f, qf[d0], p0); p1 = MFMA(k1f, qf[d0], p1);
      }
      __builtin_amdgcn_s_setprio(0);
      float mx = fmaxf(p0[0], p1[0]);
#pragma unroll
      for (int r = 1; r < 16; ++r) mx = fmaxf(mx, fmaxf(p0[r], p1[r]));
      mx = xhalf_max(mx);
      if (__builtin_amdgcn_ballot_w64(mx > m_run + 8.f) != 0ull) {
        const float m_new = fmaxf(m_run, mx); const float m_use = (m_new == -INFINITY) ? 0.f : m_new;
        const float alpha = __builtin_amdgcn_exp2f(m_run - m_use);
        l_run *= alpha; m_run = m_new;
        if (hi == 0) sc[r32] = alpha;
        __builtin_amdgcn_fence(__ATOMIC_RELEASE, "wavefront");
        __builtin_amdgcn_wave_barrier();
#pragma unroll
        for (int g4 = 0; g4 < 4; ++g4) { const f32x4 a4 = *(const f32x4*)&sc[8 * g4 + 4 * hi];
#pragma unroll
          for (int cb = 0; cb < NCB; ++cb)
#pragma unroll
            for (int j = 0; j < 4; ++j) o[cb][4 * g4 + j] *= a4[j]; }
        __builtin_amdgcn_wave_barrier();
      }
      const float m_ref = (m_run == -INFINITY) ? 0.f : m_run;
      float rs0 = 0.f, rs1 = 0.f;
#pragma unroll
      for (int r = 0; r < 16; ++r) { const float e0 = __builtin_amdgcn_exp2f(p0[r] - m_ref), e1 = __builtin_amdgcn_exp2f(p1[r] - m_ref); p0[r] = e0; p1[r] = e1; rs0 += e0; rs1 += e1; }
      l_run += xhalf_sum(rs0 + rs1);
      __builtin_amdgcn_s_setprio(1);
#pragma unroll
      for (int s = 0; s < 2; ++s) {
        const u32x4 pu0 = {pk2(p0[8 * s], p0[8 * s + 1]), pk2(p0[8 * s + 2], p0[8 * s + 3]), pk2(p0[8 * s + 4], p0[8 * s + 5]), pk2(p0[8 * s + 6], p0[8 * s + 7])};
        const u32x4 pu1 = {pk2(p1[8 * s], p1[8 * s + 1]), pk2(p1[8 * s + 2], p1[8 * s + 3]), pk2(p1[8 * s + 4], p1[8 * s + 5]), pk2(p1[8 * s + 6], p1[8 * s + 7])};
#pragma unroll
        for (int cb = 0; cb < NCB; ++cb) {
          const u32x2 lo0 = *(const u32x2*)&Vs[(cb * 32 + r32) * VLD + 16 * s + 4 * hi];
          const u32x2 hi0 = *(const u32x2*)&Vs[(cb * 32 + r32) * VLD + 16 * s + 4 * hi + 8];
          const u32x4 v0 = {lo0[0], lo0[1], hi0[0], hi0[1]};
          o[cb] = MFMA(__builtin_bit_cast(bf16x8, pu0), __builtin_bit_cast(bf16x8, v0), o[cb]);
        }
#pragma unroll
        for (int cb = 0; cb < NCB; ++cb) {
          const u32x2 lo1 = *(const u32x2*)&Vs[(cb * 32 + r32) * VLD + 32 + 16 * s + 4 * hi];
          const u32x2 hi1 = *(const u32x2*)&Vs[(cb * 32 + r32) * VLD + 32 + 16 * s + 4 * hi + 8];
          const u32x4 v1 = {lo1[0], lo1[1], hi1[0], hi1[1]};
          o[cb] = MFMA(__builtin_bit_cast(bf16x8, pu1), __builtin_bit_cast(bf16x8, v1), o[cb]);
        }
      }
      __builtin_amdgcn_s_setprio(0);
    } else
#pragma unroll 1
    for (int sub = 0; sub < 2; ++sub) {
      const int k0 = kt * 64 + sub * 32;
      if (BAND) { if (k0 > qw0 + 95 || k0 + 31 < qw0 - 64) continue; }
      f32x16 pacc;
#pragma unroll
      for (int r = 0; r < 16; ++r) pacc[r] = 0.f;
#pragma unroll
      for (int d0 = 0; d0 < ND0; ++d0) { const bf16x8 kf = *(const bf16x8*)&Ks[(sub * 32 + r32) * KLD + d0 * 16 + hi * 8]; pacc = MFMA(kf, qf[d0], pacc); }
      float mx = -INFINITY;
      if (BAND) {
#pragma unroll
        for (int r = 0; r < 16; ++r) { const int rel = k0 + crow(r, hi) - qi; const int a = rel < 0 ? -rel : rel;
          const float s = (a <= 64) ? pacc[r] - bias_step * (float)a : -INFINITY; pacc[r] = s; mx = fmaxf(mx, s); }
      } else {
#pragma unroll
        for (int r = 0; r < 16; ++r) mx = fmaxf(mx, pacc[r]);
      }
      mx = xhalf_max(mx);
      if (__builtin_amdgcn_ballot_w64(mx > m_run + 8.f) != 0ull) {
        const float m_new = fmaxf(m_run, mx); const float m_use = (m_new == -INFINITY) ? 0.f : m_new;
        const float alpha = __builtin_amdgcn_exp2f(m_run - m_use);
        l_run *= alpha; m_run = m_new;
        if (hi == 0) sc[r32] = alpha;
        __builtin_amdgcn_fence(__ATOMIC_RELEASE, "wavefront");
        __builtin_amdgcn_wave_barrier();
#pragma unroll
        for (int g4 = 0; g4 < 4; ++g4) { const f32x4 a4 = *(const f32x4*)&sc[8 * g4 + 4 * hi];
#pragma unroll
          for (int cb = 0; cb < NCB; ++cb)
#pragma unroll
            for (int j = 0; j < 4; ++j) o[cb][4 * g4 + j] *= a4[j]; }
        __builtin_amdgcn_wave_barrier();
      }
      const float m_ref = (m_run == -INFINITY) ? 0.f : m_run;
      float rs = 0.f;
#pragma unroll
      for (int r = 0; r < 16; ++r) { const float pe = __builtin_amdgcn_exp2f(pacc[r] - m_ref); pacc[r] = pe; rs += pe; }
      l_run += xhalf_sum(rs);
#pragma unroll
      for (int s = 0; s < 2; ++s) {
        const u32x4 pu = {pk2(pacc[8 * s], pacc[8 * s + 1]), pk2(pacc[8 * s + 2], pacc[8 * s + 3]), pk2(pacc[8 * s + 4], pacc[8 * s + 5]), pk2(pacc[8 * s + 6], pacc[8 * s + 7])};
        const bf16x8 pa = __builtin_bit_cast(bf16x8, pu);
#pragma unroll
        for (int cb = 0; cb < NCB; ++cb) {
          const u32x2 lo = *(const u32x2*)&Vs[(cb * 32 + r32) * VLD + sub * 32 + 16 * s + 4 * hi];
          const u32x2 h8 = *(const u32x2*)&Vs[(cb * 32 + r32) * VLD + sub * 32 + 16 * s + 4 * hi + 8];
          const u32x4 vu = {lo[0], lo[1], h8[0], h8[1]};
          o[cb] = MFMA(pa, __builtin_bit_cast(bf16x8, vu), o[cb]);
        }
      }
    }
  }
#undef ALOAD
  if (hi == 0) sc[32 + r32] = l_run;
  __builtin_amdgcn_fence(__ATOMIC_RELEASE, "wavefront");
  __builtin_amdgcn_wave_barrier();
#pragma unroll
  for (int g4 = 0; g4 < 4; ++g4) {
    const f32x4 l4 = *(const f32x4*)&sc[32 + 8 * g4 + 4 * hi];
#pragma unroll
    for (int j = 0; j < 4; ++j) {
      const float inv = 1.f / l4[j]; const int r = 4 * g4 + j; const int qrow = w * 32 + crow(r, hi);
#pragma unroll
      for (int cb = 0; cb < NCB; ++cb) {
        const unsigned pb = pk2(o[cb][r] * inv, 0.f);
        O[(size_t)qrow * ostride + cb * 32 + r32] = (u16)(pb & 0xffffu);
      }
    }
  }
  __builtin_amdgcn_wave_barrier();
  if (LSE != nullptr && hi == 0) LSE[(size_t)(w * 32 + r32) * lsestride] = (m_run + __builtin_amdgcn_logf(l_run)) * LN2;
}

DI void item_attn(const Params& p, int l, const Chunk& ck, int it, char* smem) {
  const int S = ck.S;
  if (it < 8 * MTN) {
    static_assert(8 * MTN == 1024, "MLA item swizzle assumes 1024 items");
    const int rnd = it >> 9, x = it & 7, jj = (it & 511) >> 3; const int qs = ck.sshift - 7, ppx = 64 >> qs;
    const int bh = rnd * (8 * ppx) + x * ppx + (jj >> qs), qblk = jj & ((1 << qs) - 1);
    const int h = bh & 7, bl = bh >> 3; const int t0 = qblk * 128, lt0 = bl * S + t0;
    const u16* Q = (const u16*)(p.ws + OFF_QM) + (size_t)lt0 * 768 + h * 96;
    const u16* K = (const u16*)(p.ws + OFF_KM) + (size_t)(bl * S) * 768 + h * 96;
    const u16* Vt = (const u16*)(p.ws + OFF_VMT) + ((size_t)(bl * 8 + h) * 64) * S;
    u16* O = (u16*)(p.ws + OFF_BR) + (size_t)(1 * CT + lt0) * 512 + h * 64;
    (void)t0;
    attn_block<96, 64, false>(Q, 768, K, 768, Vt, S, S, t0, 0.f, O, 512, nullptr, 0, smem);
  } else if (it < 20 * MTN) {
    const int j = it - 8 * MTN; const int x = j & 7, kk = j >> 3; const int qb = x * 16 + (kk & 15), gh = kk >> 4; const int g = gh >> 2, h = gh & 3;
    const int dsh = 2 * g, d = 1 << dsh, Lg = S >> dsh;
    const int prow0 = qb * 128; const int bl = prow0 >> ck.sshift, pp0 = prow0 & (S - 1); const int r = pp0 / Lg, u0 = pp0 - r * Lg;
    const u16* Q = (const u16*)(p.ws + OFF_QD) + ((size_t)(g * CT + bl * S + r * Lg + u0)) * 512 + h * 128;
    const u16* K = (const u16*)(p.ws + OFF_KD) + ((size_t)(g * CT + bl * S + r * Lg)) * 512 + h * 128;
    const u16* Vt = (const u16*)(p.ws + OFF_VDT) + ((size_t)((g * ck.nb + bl) * 4 + h) * 128) * S + r * Lg;
    const float slope = __builtin_amdgcn_exp2f(-8.f * (float)(g * 4 + h + 1) / 12.f);
    const size_t tokrow = (size_t)g * CT + bl * S + (size_t)u0 * d + r;
    u16* O = (u16*)(p.ws + OFF_AO) + tokrow * 512 + h * 128;
    float* LSE = (float*)(p.ws + OFF_LSE) + tokrow * 4 + h;
    attn_block<128, 128, true>(Q, 512, K, 512, Vt, S, Lg, u0, slope * (float)d * LOG2E, O, d * 512, LSE, d * 4, smem);
  } else {
    const int j = it - 20 * MTN; const int x = j & 7, kk = j >> 3; const int qb = x * 16 + (kk & 15), h = kk >> 4; const int lt0 = qb * 128; const int bl = lt0 >> ck.sshift;
    const int gb = ck.mb0 + bl;
    const u16* Q = (const u16*)(p.ws + OFF_MQ) + (size_t)lt0 * 512 + h * 128;
    const u16* K = (const u16*)(p.ws + OFF_KMEM + l * SZ_KMEM) + (size_t)(gb * 256) * 512 + h * 128;
    const u16* Vt = (const u16*)(p.ws + OFF_VMEMT + l * SZ_KMEM) + ((size_t)(gb * 4 + h) * 128) * 256;
    u16* O = (u16*)(p.ws + OFF_BR) + (size_t)(2 * CT + lt0) * 512 + h * 128;
    attn_block<128, 128, false>(Q, 512, K, 512, Vt, 256, 256, 0, 0.f, O, 512, nullptr, 0, smem);
  }
}

DI void phase_merge(const Params& p) {
  const int gsz = gridDim.x * 256;
  const u16* AO = (const u16*)(p.ws + OFF_AO); const float* LSE = (const float*)(p.ws + OFF_LSE); u16* BR0 = (u16*)(p.ws + OFF_BR);
  for (int i = BID() * 256 + TID(); i < CT * 64; i += gsz) {
    const int lt = i >> 6, c8 = i & 63, h = c8 >> 4;
    const float l0 = LSE[(size_t)(0 * CT + lt) * 4 + h], l1 = LSE[(size_t)(1 * CT + lt) * 4 + h], l2 = LSE[(size_t)(2 * CT + lt) * 4 + h];
    const float mx = fmaxf(l0, fmaxf(l1, l2));
    float w0 = __expf(l0 - mx), w1 = __expf(l1 - mx), w2 = __expf(l2 - mx); const float inv = 1.f / (w0 + w1 + w2); w0 *= inv; w1 *= inv; w2 *= inv;
    float a[8], b[8], c[8], o[8];
    unpack8(*(const u32x4*)(AO + (size_t)(0 * CT + lt) * 512 + c8 * 8), a);
    unpack8(*(const u32x4*)(AO + (size_t)(1 * CT + lt) * 512 + c8 * 8), b);
    unpack8(*(const u32x4*)(AO + (size_t)(2 * CT + lt) * 512 + c8 * 8), c);
#pragma unroll
    for (int j = 0; j < 8; ++j) o[j] = w0 * a[j] + w1 * b[j] + w2 * c[j];
    st8(BR0 + (size_t)lt * 512 + c8 * 8, o);
  }
}

DI void tile_branch(const Params& p, int l, int tile, char* smem) {
  float* Cs = (float*)smem;
  const int tid = TID(), lane = tid & 63, w = tid >> 6, wm = w >> 1, wn = w & 1, r32 = lane & 31, hi = lane >> 5;
  const int mi = tile & (MTN - 1), ni = tile >> MTS; const int m0 = mi * 128, n0 = ni * 128;
  unsigned upk[2][2][8];
#pragma unroll
  for (int a = 0; a < 2; ++a)
#pragma unroll
    for (int b = 0; b < 2; ++b)
#pragma unroll
      for (int i = 0; i < 8; ++i) upk[a][b][i] = 0u;
  float* rinv_s = (float*)(smem + SMEM_CS);
  { const RowSS rss = rowss_load((const float*)(p.ws + OFF_PSIN), m0); rowss_finish(rss, rinv_s); }
#pragma unroll 1
  for (int br = 0; br < 3; ++br) {
    unsigned gpk[2][2][8];
    {
      f32x16 accg[2][2]; zero_acc(accg);
      gemm_main_bf<false, 16>((const u16*)(p.ws + OFF_XB) + (size_t)m0 * 1024, 1024,
                              (const u16*)(p.ws + OFF_WIN + l * SZ_WIN) + (size_t)(5760 + br * 1024 + n0) * 1024, accg, smem, nullptr);
      __syncthreads();
#pragma unroll
      for (int mt = 0; mt < 2; ++mt)
#pragma unroll
        for (int g4 = 0; g4 < 4; ++g4) {
          const f32x4 r4 = *(const f32x4*)&rinv_s[wm * 64 + mt * 32 + 8 * g4 + 4 * hi];
#pragma unroll
          for (int nt = 0; nt < 2; ++nt) {
            const float s0 = 1.f / (1.f + __expf(-accg[mt][nt][4 * g4 + 0] * r4[0])), s1 = 1.f / (1.f + __expf(-accg[mt][nt][4 * g4 + 1] * r4[1]));
            const float s2 = 1.f / (1.f + __expf(-accg[mt][nt][4 * g4 + 2] * r4[2])), s3 = 1.f / (1.f + __expf(-accg[mt][nt][4 * g4 + 3] * r4[3]));
            gpk[mt][nt][2 * g4] = pk2(s0, s1); gpk[mt][nt][2 * g4 + 1] = pk2(s2, s3);
          }
        }
    }
    f32x16 acc[2][2]; zero_acc(acc);
    gemm_main_bf<false, 8>((const u16*)(p.ws + OFF_BR) + (size_t)(br * CT + m0) * 512, 512,
                            (const u16*)(p.ws + OFF_WBR + (l * 3 + br) * SZ_WBR) + (size_t)n0 * 512, acc, smem, nullptr);
#pragma unroll
    for (int mt = 0; mt < 2; ++mt)
#pragma unroll
      for (int nt = 0; nt < 2; ++nt)
#pragma unroll
        for (int i = 0; i < 8; ++i) {
          const float g0 = __uint_as_float(gpk[mt][nt][i] << 16), g1 = __uint_as_float(gpk[mt][nt][i] & 0xffff0000u);
          const float a = __uint_as_float(upk[mt][nt][i] << 16) + g0 * acc[mt][nt][2 * i];
          const float b = __uint_as_float(upk[mt][nt][i] & 0xffff0000u) + g1 * acc[mt][nt][2 * i + 1];
          upk[mt][nt][i] = pk2(a, b);
        }
  }
  __syncthreads();
#pragma unroll
  for (int mt = 0; mt < 2; ++mt)
#pragma unroll
    for (int nt = 0; nt < 2; ++nt)
#pragma unroll
      for (int i = 0; i < 8; ++i) {
        const int cc = wn * 64 + nt * 32 + r32;
        Cs[(wm * 64 + mt * 32 + crow(2 * i, hi)) * CSL + cc] = __uint_as_float(upk[mt][nt][i] << 16);
        Cs[(wm * 64 + mt * 32 + crow(2 * i + 1, hi)) * CSL + cc] = __uint_as_float(upk[mt][nt][i] & 0xffff0000u);
      }
  __syncthreads();
  const int row = tid >> 1, half = tid & 1; float v[8];
  u16* dst = (u16*)(p.ws + OFF_U) + (size_t)(m0 + row) * 1024 + n0 + half * 64;
#pragma unroll
  for (int c8 = 0; c8 < 8; ++c8) { cs_ld8(Cs, row, half * 64 + c8 * 8, v); st8(dst + c8 * 8, v); }
}

DI void outproj_ptrs(const Params& p, int l, int tile, const u16*& Ap, const u16*& Wt) {
  const int mi = tile & (MTN - 1), ni = tile >> MTS;
  Ap = (const u16*)(p.ws + OFF_U) + (size_t)(mi * 128) * 1024; Wt = (const u16*)(p.ws + OFF_WOUT + l * SZ_WOUT) + (size_t)(ni * 128) * 1024;
}
DI void tile_outproj(const Params& p, int l, const Chunk& ck, int tile, int next, PF& pf, char* smem) {
  float* Cs = (float*)smem;
  const int tid = TID(); const int mi = tile & (MTN - 1), ni = tile >> MTS; const int m0 = mi * 128, n0 = ni * 128;
  f32x16 acc[2][2]; zero_acc(acc);
  { const u16* Ap; const u16* Wt; outproj_ptrs(p, l, tile, Ap, Wt); gemm_run<16>(pf, Ap, 1024, Wt, acc, smem); }
  if (next >= 0) { const u16* An; const u16* Wn; outproj_ptrs(p, l, next, An, Wn); gemm_issue(pf, An, 1024, Wn, 1024); }
  acc_to_cs(acc, Cs);
  const int row = tid >> 1, half = tid & 1; float ssq = 0.f;
  u16* xb = (u16*)(p.ws + OFF_XB) + (size_t)(m0 + row) * 1024 + n0 + half * 64;
#pragma unroll
  for (int c8 = 0; c8 < 8; ++c8) {
    float v[8], x[8]; cs_ld8(Cs, row, half * 64 + c8 * 8, v); unpack8(*(const u32x4*)(xb + c8 * 8), x);
#pragma unroll
    for (int j = 0; j < 8; ++j) { v[j] += x[j]; ssq += v[j] * v[j]; }
    *(u32x4*)(xb + c8 * 8) = pack8(v);
  }
  ((float*)(p.ws + OFF_PSMID))[(size_t)(m0 + row) * 16 + ni * 2 + half] = ssq;
}

DI void ffn1_ptrs(const Params& p, int l, int tile, const u16*& Ap, const u16*& Wt) {
  const int mi = tile & (MTN - 1), ni = tile >> MTS;
  Ap = (const u16*)(p.ws + OFF_XB) + (size_t)(mi * 128) * 1024; Wt = (const u16*)(p.ws + OFF_WFF1 + l * SZ_WFF1) + (size_t)(ni * 128) * 1024;
}
DI void tile_ffn1(const Params& p, int l, const Chunk& ck, int tile, int next, PF& pf, char* smem) {
  float* Cs = (float*)smem; float* rinv_s = (float*)(smem + SMEM_CS);
  const int tid = TID(); const int mi = tile & (MTN - 1), ni = tile >> MTS; const int m0 = mi * 128, n0 = ni * 128;
  f32x16 acc[2][2]; zero_acc(acc);
  const RowSS rss = rowss_load((const float*)(p.ws + OFF_PSMID), m0);
  { const u16* Ap; const u16* Wt; ffn1_ptrs(p, l, tile, Ap, Wt); gemm_run<16>(pf, Ap, 1024, Wt, acc, smem); }
  if (next >= 0) { const u16* An; const u16* Wn; ffn1_ptrs(p, l, next, An, Wn); gemm_issue(pf, An, 1024, Wn, 1024); }
  rowss_finish(rss, rinv_s);
  acc_to_cs(acc, Cs);
  const int row = tid >> 1, half = tid & 1; const float rinv = rinv_s[row]; float v[8];
  u16* dst = (u16*)(p.ws + OFF_H) + (size_t)(m0 + row) * 4096 + n0 + half * 64;
#pragma unroll
  for (int c8 = 0; c8 < 8; ++c8) { cs_ld8(Cs, row, half * 64 + c8 * 8, v);
#pragma unroll
    for (int j = 0; j < 8; ++j) { const float r = fmaxf(v[j] * rinv, 0.f); v[j] = r * r; }
    st8(dst + c8 * 8, v); }
}

DI void ffn2_ptrs(const Params& p, int l, int tile, const u16*& Ap, const u16*& Wt) {
  const int mi = tile & (MTN - 1), ni = tile >> MTS;
  Ap = (const u16*)(p.ws + OFF_H) + (size_t)(mi * 128) * 4096; Wt = (const u16*)(p.ws + OFF_WFF2 + l * SZ_WFF2) + (size_t)(ni * 128) * 4096;
}
DI void tile_ffn2(const Params& p, int l, const Chunk& ck, int tile, int next, PF& pf, char* smem) {
  float* Cs = (float*)smem;
  const int tid = TID(); const int mi = tile & (MTN - 1), ni = tile >> MTS; const int m0 = mi * 128, n0 = ni * 128;
  f32x16 acc[2][2]; zero_acc(acc);
  { const u16* Ap; const u16* Wt; ffn2_ptrs(p, l, tile, Ap, Wt); gemm_run<64>(pf, Ap, 4096, Wt, acc, smem); }
  if (next >= 0) { const u16* An; const u16* Wn; ffn2_ptrs(p, l, next, An, Wn); gemm_issue(pf, An, 4096, Wn, 4096); }
  acc_to_cs(acc, Cs);
  const int row = tid >> 1, half = tid & 1; float ssq = 0.f;
  float* xd = p.out + (size_t)(ck.tok0 + m0 + row) * 1024 + n0 + half * 64;
  u16* xb = (u16*)(p.ws + OFF_XB) + (size_t)(m0 + row) * 1024 + n0 + half * 64;
#pragma unroll
  for (int c8 = 0; c8 < 8; ++c8) {
    float v[8], x[8]; cs_ld8(Cs, row, half * 64 + c8 * 8, v); unpack8(*(const u32x4*)(xb + c8 * 8), x);
#pragma unroll
    for (int j = 0; j < 8; ++j) { v[j] += x[j]; ssq += v[j] * v[j]; }
    if (l == 0) *(u32x4*)(xb + c8 * 8) = pack8(v);
    else { *(f32x4*)(xd + c8 * 8) = f32x4{v[0], v[1], v[2], v[3]}; *(f32x4*)(xd + c8 * 8 + 4) = f32x4{v[4], v[5], v[6], v[7]}; }
  }
  if (l == 0) ((float*)(p.ws + OFF_PSIN))[(size_t)(m0 + row) * 16 + ni * 2 + half] = ssq;
}


DI void phase_convert(const Params& p, const Chunk& ck) {
  const float* xsrc = chunk_xsrc(p, 0, ck);
  u16* xb = (u16*)(p.ws + OFF_XB); float* ps = (float*)(p.ws + OFF_PSIN);
  const int tid = TID(), lane = tid & 63, w = tid >> 6;
  for (int row = BID() * 4 + w; row < CT; row += gridDim.x * 4) {
    float ss = 0.f;
#pragma unroll
    for (int i = 0; i < 2; ++i) {
      const int c = (lane + 64 * i) * 8;
      const f32x4 a = *(const f32x4*)(xsrc + (size_t)row * 1024 + c), b = *(const f32x4*)(xsrc + (size_t)row * 1024 + c + 4);
      ss += a[0] * a[0] + a[1] * a[1] + a[2] * a[2] + a[3] * a[3] + b[0] * b[0] + b[1] * b[1] + b[2] * b[2] + b[3] * b[3];
      *(u32x4*)(xb + (size_t)row * 1024 + c) = u32x4{pk2(a[0], a[1]), pk2(a[2], a[3]), pk2(b[0], b[1]), pk2(b[2], b[3])};
    }
#pragma unroll
    for (int o = 32; o >= 1; o >>= 1) ss += __shfl_xor(ss, o);
    if (lane < 16) ps[(size_t)row * 16 + lane] = (lane == 0) ? ss : 0.f;
  }
}

#define XB_TMO      128
#define XB_XCNT(j)  (256  + 64 * (j))
#define XB_XSUB(j)  (1280 + 64 * (j))
#define XB_XGEN(j)  (2304 + 64 * (j))
#define XB_TOP      3328
#define XB_TOPGEN   3392
#define XCD_BAR_WORDS 3456
#define XB_SPIN_CAP (1u << 22)
#define LAS __attribute__((address_space(3)))
DI unsigned xb_ld(unsigned* p)              { return __hip_atomic_load(p, __ATOMIC_RELAXED, __HIP_MEMORY_SCOPE_AGENT); }
DI unsigned xb_add(unsigned* p, unsigned v) { return __hip_atomic_fetch_add(p, v, __ATOMIC_RELAXED, __HIP_MEMORY_SCOPE_AGENT); }
DI unsigned xb_xcc_id() { return (unsigned)__builtin_amdgcn_s_getreg((3 << 11) | 20) & 0xFu; }
#define XB_SPIN(cond, bar) do { unsigned _sp = 0; while (cond) { __builtin_amdgcn_s_sleep(1); \
    if ((++_sp & 255u) == 0u) { if (xb_ld(&(bar)[XB_TMO])) break; if (_sp > XB_SPIN_CAP) { atomicAdd(&(bar)[XB_TMO], 1u); break; } } } } while (0)
struct XcdBarrier { unsigned* bar; unsigned x; volatile LAS unsigned* st; };
DI XcdBarrier xcd_barrier_post(unsigned* bar, volatile LAS unsigned* st) {
  XcdBarrier b; b.bar = bar; b.x = xb_xcc_id(); b.st = st;
  if (threadIdx.x == 0) (void)xb_add(&bar[XB_XCNT(b.x)], 1u);
  return b;
}
DI void xcd_barrier_complete(unsigned* bar, unsigned x, unsigned& nloc, unsigned& nx) {
  const unsigned G = gridDim.x * gridDim.y * gridDim.z;
  unsigned sum, cnt, mine, sp = 0u;
  for (;;) {
    sum = 0u; cnt = 0u; mine = 0u;
#pragma unroll
    for (unsigned j = 0; j < 16; ++j) { const unsigned c = xb_ld(&bar[XB_XCNT(j)]); sum += c; cnt += (c > 0u) ? 1u : 0u; mine = (j == x) ? c : mine; }
    if (sum == G) break;
    __builtin_amdgcn_s_sleep(1);
    if ((++sp & 255u) == 0u) { if (xb_ld(&bar[XB_TMO])) break; if (sp > XB_SPIN_CAP) { atomicAdd(&bar[XB_TMO], 1u); break; } }
  }
  nloc = mine > 0u ? mine : 1u; nx = cnt > 0u ? cnt : 1u;
}
DI void xcd_barrier(const XcdBarrier& b) {
  asm volatile("s_waitcnt vmcnt(0)" ::: "memory");
  __syncthreads();
  if (threadIdx.x == 0) {
    unsigned* bar = b.bar;
    __builtin_amdgcn_s_waitcnt(0);
    unsigned nloc = b.st[0], nx = b.st[1];
    if (nloc == 0u) { xcd_barrier_complete(bar, b.x, nloc, nx); b.st[0] = nloc; b.st[1] = nx; }
    const unsigned old = xb_add(&bar[XB_XSUB(b.x)], 1u);
    const unsigned gen = old / nloc;
    if (old + 1u == (gen + 1u) * nloc) {
      __builtin_amdgcn_fence(__ATOMIC_RELEASE, "agent");
      asm volatile("s_waitcnt vmcnt(0)" ::: "memory");
      const unsigned og = xb_add(&bar[XB_TOP], 1u);
      const unsigned tg = og / nx;
      if (og + 1u == (tg + 1u) * nx) xb_add(&bar[XB_TOPGEN], 1u);
      else XB_SPIN(xb_ld(&bar[XB_TOPGEN]) == tg, bar);
      __builtin_amdgcn_fence(__ATOMIC_ACQUIRE, "agent");
      xb_add(&bar[XB_XGEN(b.x)], 1u);
      asm volatile("s_waitcnt vmcnt(0)" ::: "memory");
    } else {
      XB_SPIN(xb_ld(&bar[XB_XGEN(b.x)]) == gen, bar);
      __builtin_amdgcn_fence(__ATOMIC_ACQUIRE, "agent");
      asm volatile("s_waitcnt vmcnt(0)" ::: "memory");
    }
  }
  __syncthreads();
}

enum { PH_PREP = 0, PH_MEMKV, PH_INPROJ, PH_MLAUP, PH_ATTN, PH_MERGE, PH_BRANCH, PH_OUTPROJ, PH_FFN1, PH_FFN2, PH_CONVERT };
DI void run_phase(const Params& p, int ph, int l, int c, char* smem) {
  const Chunk ck = make_chunk(c);
  switch (ph) {
    case PH_MEMKV: for (int t = BID(); t < 48 * 8; t += gridDim.x) tile_memkv(p, l, t, smem); break;
    case PH_INPROJ: {
      PF pf; int t = BID();
      if (t < MTN * 46) { const u16* A0; const u16* W0; inproj_ptrs(p, l, t, A0, W0); gemm_issue(pf, A0, 1024, W0, 1024); }
      for (; t < MTN * 46; t += gridDim.x) { const int tn = t + (int)gridDim.x; tile_inproj(p, l, ck, t, tn < MTN * 46 ? tn : -1, pf, smem); }
    } break;
    case PH_MLAUP: for (int t = BID(); t < MTN * 16; t += gridDim.x) tile_mla_up(p, l, ck, t, smem); break;
    case PH_ATTN: for (int t = BID(); t < 24 * MTN; t += gridDim.x) item_attn(p, l, ck, t, smem); break;
    case PH_MERGE: phase_merge(p); break;
    case PH_BRANCH: for (int t = BID(); t < MTN * 8; t += gridDim.x) tile_branch(p, l, t, smem); break;
    case PH_OUTPROJ: {
      PF pf; int t = BID();
      if (t < MTN * 8) { const u16* A0; const u16* W0; outproj_ptrs(p, l, t, A0, W0); gemm_issue(pf, A0, 1024, W0, 1024); }
      for (; t < MTN * 8; t += gridDim.x) { const int tn = t + (int)gridDim.x; tile_outproj(p, l, ck, t, tn < MTN * 8 ? tn : -1, pf, smem); }
    } break;
    case PH_FFN1: {
      PF pf; int t = BID();
      if (t < MTN * 32) { const u16* A0; const u16* W0; ffn1_ptrs(p, l, t, A0, W0); gemm_issue(pf, A0, 1024, W0, 1024); }
      for (; t < MTN * 32; t += gridDim.x) { const int tn = t + (int)gridDim.x; tile_ffn1(p, l, ck, t, tn < MTN * 32 ? tn : -1, pf, smem); }
    } break;
    case PH_CONVERT: phase_convert(p, ck); break;
    default: {
      PF pf; int t = BID();
      if (t < MTN * 8) { const u16* A0; const u16* W0; ffn2_ptrs(p, l, t, A0, W0); gemm_issue(pf, A0, 4096, W0, 4096); }
      for (; t < MTN * 8; t += gridDim.x) { const int tn = t + (int)gridDim.x; tile_ffn2(p, l, ck, t, tn < MTN * 8 ? tn : -1, pf, smem); }
    } break;
  }
}

__global__ void __launch_bounds__(256, 2) phase_kernel(Params p, int ph, int l, int c) {
  __shared__ __attribute__((aligned(16))) char smem[SMEM_BYTES];
  if (ph == PH_PREP) phase_prep(p, smem); else run_phase(p, ph, l, c, smem);
}

__global__ void __launch_bounds__(256, 2) mega_kernel(Params p) {
  __shared__ __attribute__((aligned(16))) char smem[SMEM_BYTES];
  __shared__ uint4 xb_words;
  cg::grid_group grid = cg::this_grid();
  if (threadIdx.x == 0) xb_words = make_uint4(0u, 0u, 0u, 0u);
  __syncthreads();
  const XcdBarrier xb = xcd_barrier_post((unsigned*)(p.ws + OFF_BAR), (volatile LAS unsigned*)&xb_words);
  phase_prep(p, smem);
  grid.sync();
#pragma unroll 1
  for (int step = 0; step < 2 + NCHUNK * 17; ++step) {
    int ph, l, c = 0;
    if (step < 2) { ph = PH_MEMKV; l = step; }
    else { const int s = step - 2; c = s / 17; const int r = s - c * 17; if (r == 0) { ph = PH_CONVERT; l = 0; } else { l = (r - 1) >> 3; ph = PH_INPROJ + ((r - 1) & 7); } }
    GAS const float* xp = (GAS const float*)p.x_prompt; GAS const float* xs = (GAS const float*)p.x_sample; GAS const float* mp = (GAS const float*)p.mem_prompt;
    GAS const float* ms = (GAS const float*)p.mem_sample; GAS float* po = (GAS float*)p.out; GAS char* pw = (GAS char*)p.ws;
    asm volatile("" : "+s"(xp), "+s"(xs), "+s"(mp), "+s"(ms), "+s"(po), "+s"(pw));
    Params q{};
    q.x_prompt = (const float*)xp; q.x_sample = (const float*)xs; q.mem_prompt = (const float*)mp; q.mem_sample = (const float*)ms; q.out = (float*)po; q.ws = (char*)pw;
    run_phase(q, ph, l, c, smem);
    xcd_barrier(xb);
  }
}

extern "C" void kernel_launch(void* const* d_in, const int* in_sizes, int n_in, void* d_out, int out_size, void* d_ws, size_t ws_size, hipStream_t stream) {
  if (n_in != 23 || ws_size < WS_END || out_size != 65536 * 1024) {
    fprintf(stderr, "kernel_launch: unexpected shapes: n_in %d out %d ws %zu (need %zu)\n", n_in, out_size, ws_size, (size_t)WS_END);
    return;
  }
  Params p{};
  const float** pf = (const float**)&p;
  for (int i = 0; i < 23; ++i) pf[i] = (const float*)d_in[i];
  p.out = (float*)d_out; p.ws = (char*)d_ws;
  static int grid = 0;
  if (grid == 0) {
    int dev = 0, cus = 0, per_cu = 0;
    hipGetDevice(&dev);
    hipDeviceGetAttribute(&cus, hipDeviceAttributeMultiprocessorCount, dev);
#if MULTI_LAUNCH
    hipOccupancyMaxActiveBlocksPerMultiprocessor(&per_cu, phase_kernel, 256, 0);
#else
    hipOccupancyMaxActiveBlocksPerMultiprocessor(&per_cu, mega_kernel, 256, 0);
#endif
    if (per_cu < 1) per_cu = 1;
    if (per_cu > 2) per_cu = 2;
    grid = cus * per_cu;
  }
#if MULTI_LAUNCH
  hipLaunchKernelGGL(phase_kernel, dim3(grid), dim3(256), 0, stream, p, (int)PH_PREP, 0, 0);
  for (int l = 0; l < 2; ++l) hipLaunchKernelGGL(phase_kernel, dim3(grid), dim3(256), 0, stream, p, (int)PH_MEMKV, l, 0);
  for (int c = 0; c < NCHUNK; ++c) {
    hipLaunchKernelGGL(phase_kernel, dim3(grid), dim3(256), 0, stream, p, (int)PH_CONVERT, 0, c);
    for (int l = 0; l < 2; ++l)
      for (int ph = PH_INPROJ; ph <= PH_FFN2; ++ph) hipLaunchKernelGGL(phase_kernel, dim3(grid), dim3(256), 0, stream, p, ph, l, c);
  }
#else
  hipMemsetAsync((char*)d_ws + OFF_BAR, 0, 16384, stream);
  void* args[] = {&p};
  hipError_t e = hipLaunchCooperativeKernel((void*)mega_kernel, dim3(grid), dim3(256), args, 0, stream);
  if (e != hipSuccess) fprintf(stderr, "cooperative launch failed: %s (grid %d)\n", hipGetErrorString(e), grid);
#endif
}
```
